# Optimizing an MI355X kernel written in HIP

```python
import jax, jax.numpy as jnp
from jax import lax
import numpy as np

D_MODEL = 1024
BATCH = 16
SEQ = 2048
DEPTH = 4

CONV_WIDTH = D_MODEL
CONV_K = 3
SGU_WIDTH = D_MODEL
SGU_CHUNK = 128
SGU_HEADS = 8
SGU_HEAD_DIM = SGU_WIDTH // SGU_HEADS
LRU_WIDTH = D_MODEL
LRU_HEADS = 16
LRU_HEAD_DIM = LRU_WIDTH // LRU_HEADS
LRU_CONV_K = 4
LRU_C = 8.0
N_BRANCH = 3
IN_COLS = 4 * CONV_WIDTH + 3 * SGU_WIDTH + 2 * LRU_WIDTH + N_BRANCH * D_MODEL
EPS = 1e-6

kernel_name = "hybrid_gated_conv_sgu_rglru"


def rms_norm(x, g):
    xf = x.astype(jnp.float32)
    y = xf * lax.rsqrt(jnp.mean(xf * xf, axis=-1, keepdims=True) + EPS)
    return (y * g.astype(jnp.float32)).astype(x.dtype)


def causal_dwconv(u, w):
    k = w.shape[0]
    s = u.shape[1]
    up = jnp.pad(u, ((0, 0), (k - 1, 0), (0, 0)))
    return sum(w[j] * up[:, j:j + s] for j in range(k))


def short_conv_mixer(x_a, b_gate, c_gate, w_conv):
    return b_gate * causal_dwconv(c_gate * x_a, w_conv)


def sgu_mixer(u, v, w_s, b_s):
    bsz, s, _ = v.shape
    nc = s // SGU_CHUNK
    vh = v.reshape(bsz, nc, SGU_CHUNK, SGU_HEADS, SGU_HEAD_DIM)
    vf = vh.astype(jnp.float32)
    mu = jnp.mean(vf, axis=-1, keepdims=True)
    var = jnp.mean(jnp.square(vf - mu), axis=-1, keepdims=True)
    vn = ((vf - mu) * lax.rsqrt(var + EPS)).astype(v.dtype)
    causal = jnp.tril(jnp.ones((SGU_CHUNK, SGU_CHUNK), dtype=bool))
    ws = jnp.where(causal[None], w_s, jnp.zeros_like(w_s))
    z = jnp.einsum("hts,bnshd->bnthd", ws, vn) + b_s.T[None, None, :, :, None]
    return u * z.reshape(bsz, s, SGU_WIDTH)


def rg_lru_mixer(x_r, w_conv, b_conv, w_a, b_a, w_x, b_x, lam):
    bsz, s, _ = x_r.shape
    xc = causal_dwconv(x_r, w_conv) + b_conv
    xh = xc.reshape(bsz, s, LRU_HEADS, LRU_HEAD_DIM)
    r = jax.nn.sigmoid(jnp.einsum("bshd,hde->bshe", xh, w_a) + b_a).reshape(bsz, s, LRU_WIDTH)
    i = jax.nn.sigmoid(jnp.einsum("bshd,hde->bshe", xh, w_x) + b_x).reshape(bsz, s, LRU_WIDTH)
    log_a = -LRU_C * r.astype(jnp.float32) * jax.nn.softplus(-lam.astype(jnp.float32))
    a = jnp.exp(log_a)
    mult = jnp.sqrt(-jnp.expm1(2.0 * log_a))
    b = mult * (i * xc).astype(jnp.float32)

    def combine(left, right):
        a_l, b_l = left
        a_r, b_r = right
        return a_l * a_r, a_r * b_l + b_r

    _, h = lax.associative_scan(combine, (a, b), axis=1)
    return h.astype(x_r.dtype)


def hybrid_layer(x, c_act, gain, w_mod, b_mod, w_in, w_out, conv_a_w, sgu_w, sgu_b,
                 lru_conv_w, lru_conv_b, lru_wa, lru_ba, lru_wx, lru_bx, lru_lambda):
    mod = c_act @ w_mod + b_mod
    shift, scale, gate = jnp.split(mod, 3, axis=-1)
    h = rms_norm(x, gain) * (1.0 + scale[:, None, :]) + shift[:, None, :]
    proj = h @ w_in
    sizes = (CONV_WIDTH,) * 4 + (SGU_WIDTH,) * 3 + (LRU_WIDTH,) * 2 + (D_MODEL,) * N_BRANCH
    splits = np.cumsum(sizes)[:-1].tolist()
    (a_x, a_b, a_c, a_z, s_u, s_v, s_z, r_x, r_z, g_a, g_s, g_r) = jnp.split(proj, splits, axis=-1)
    y_a = jax.nn.silu(a_z) * short_conv_mixer(a_x, a_b, a_c, conv_a_w)
    y_s = jax.nn.silu(s_z) * sgu_mixer(s_u, s_v, sgu_w, sgu_b)
    y_r = jax.nn.silu(r_z) * rg_lru_mixer(r_x, lru_conv_w, lru_conv_b, lru_wa, lru_ba,
                                          lru_wx, lru_bx, lru_lambda)
    merged = jax.nn.sigmoid(g_a) * y_a + jax.nn.sigmoid(g_s) * y_s + jax.nn.sigmoid(g_r) * y_r
    return x + gate[:, None, :] * (merged @ w_out)


def setup_inputs(seed: int = 0) -> dict:
    key = jax.random.key(seed)
    ks = jax.random.split(key, 20)
    nrm = jax.random.normal
    d = D_MODEL
    x = nrm(ks[0], (BATCH, SEQ, d), jnp.float32)
    c = nrm(ks[1], (BATCH, d), jnp.float32)
    norm_gain = 1.0 + 0.05 * nrm(ks[2], (DEPTH, d), jnp.float32)
    w_mod = 0.1 * d ** -0.5 * nrm(ks[3], (DEPTH, d, 3 * d), jnp.float32)
    b_mod = 0.02 * nrm(ks[4], (DEPTH, 3 * d), jnp.float32)
    w_in = d ** -0.5 * nrm(ks[5], (DEPTH, d, IN_COLS), jnp.float32)
    w_out = d ** -0.5 * nrm(ks[6], (DEPTH, d, d), jnp.float32)
    conv_a_w = CONV_K ** -0.5 * nrm(ks[7], (DEPTH, CONV_K, CONV_WIDTH), jnp.float32)
    sgu_w = SGU_CHUNK ** -0.5 * nrm(ks[8], (DEPTH, SGU_HEADS, SGU_CHUNK, SGU_CHUNK), jnp.float32)
    sgu_b = 1.0 + 0.1 * nrm(ks[9], (DEPTH, SGU_HEADS, SGU_CHUNK), jnp.float32)
    lru_conv_w = LRU_CONV_K ** -0.5 * nrm(ks[10], (DEPTH, LRU_CONV_K, LRU_WIDTH), jnp.float32)
    lru_conv_b = 0.02 * nrm(ks[11], (DEPTH, LRU_WIDTH), jnp.float32)
    lru_wa = LRU_HEAD_DIM ** -0.5 * nrm(ks[12], (DEPTH, LRU_HEADS, LRU_HEAD_DIM, LRU_HEAD_DIM), jnp.float32)
    lru_ba = 0.02 * nrm(ks[13], (DEPTH, LRU_HEADS, LRU_HEAD_DIM), jnp.float32)
    lru_wx = LRU_HEAD_DIM ** -0.5 * nrm(ks[14], (DEPTH, LRU_HEADS, LRU_HEAD_DIM, LRU_HEAD_DIM), jnp.float32)
    lru_bx = 0.02 * nrm(ks[15], (DEPTH, LRU_HEADS, LRU_HEAD_DIM), jnp.float32)
    a_c = jax.random.uniform(ks[16], (DEPTH, LRU_WIDTH), jnp.float32, 0.9, 0.999)
    a_base = a_c ** (1.0 / LRU_C)
    lru_lambda = jnp.log(a_base) - jnp.log1p(-a_base)
    final_gain = 1.0 + 0.05 * nrm(ks[17], (d,), jnp.float32)
    return {"x": x, "c": c, "norm_gain": norm_gain, "w_mod": w_mod, "b_mod": b_mod,
            "w_in": w_in, "w_out": w_out, "conv_a_w": conv_a_w, "sgu_w": sgu_w, "sgu_b": sgu_b,
            "lru_conv_w": lru_conv_w, "lru_conv_b": lru_conv_b, "lru_wa": lru_wa, "lru_ba": lru_ba,
            "lru_wx": lru_wx, "lru_bx": lru_bx, "lru_lambda": lru_lambda, "final_gain": final_gain}


def reference(x, c, norm_gain, w_mod, b_mod, w_in, w_out, conv_a_w, sgu_w, sgu_b,
              lru_conv_w, lru_conv_b, lru_wa, lru_ba, lru_wx, lru_bx, lru_lambda, final_gain):
    c_act = jax.nn.silu(c)
    for l in range(DEPTH):
        x = hybrid_layer(x, c_act, norm_gain[l], w_mod[l], b_mod[l], w_in[l], w_out[l],
                         conv_a_w[l], sgu_w[l], sgu_b[l], lru_conv_w[l], lru_conv_b[l],
                         lru_wa[l], lru_ba[l], lru_wx[l], lru_bx[l], lru_lambda[l])
    return rms_norm(x, final_gain)
```

```cpp
#include <hip/hip_runtime.h>
#include <hip/hip_cooperative_groups.h>
#include <cstdio>
#include <cstdint>
namespace cg = cooperative_groups;

#define LAS __attribute__((address_space(3)))
typedef unsigned short bf16_t;
typedef short bf16x8 __attribute__((ext_vector_type(8)));
typedef float f32x4 __attribute__((ext_vector_type(4)));
typedef float f32x2 __attribute__((ext_vector_type(2)));
typedef unsigned u32x4 __attribute__((ext_vector_type(4)));
typedef unsigned u32x2 __attribute__((ext_vector_type(2)));

constexpr int D = 1024, NB = 16, SEQ = 2048, M = NB * SEQ, DEPTH = 4, NIN = 12288;
constexpr float EPS = 1e-6f;
constexpr size_t MiB = 1u << 20;
constexpr size_t WS_WIN = 0;
constexpr size_t WS_WOUT = 96 * MiB;
constexpr size_t WS_WSB = 104 * MiB;
constexpr size_t WS_WA = 105 * MiB;
constexpr size_t WS_WX = 105 * MiB + 512 * 1024;
constexpr size_t WS_MOD = 106 * MiB;
constexpr size_t WS_H = 112 * MiB;
constexpr size_t WS_MRG = 176 * MiB;
constexpr size_t WS_P = 240 * MiB, WS_QA = 304 * MiB, WS_V = 368 * MiB, WS_QS = 432 * MiB, WS_XR = 496 * MiB, WS_QR = 560 * MiB, WS_SGA = 624 * MiB;
constexpr size_t WS_VST = 688 * MiB;
constexpr size_t WS_RSS = 704 * MiB;
constexpr size_t WS_BIAS = 107 * MiB;
constexpr size_t WS_GP = 110 * MiB;
constexpr size_t WS_CTL = 706 * MiB, CTL_BYTES = 16384;
constexpr size_t WS_END = 707 * MiB;
constexpr int LDS_BYTES = 147456;
constexpr int LDS_RSTD = 133120, LDS_PMS = 141312, LDS_BIAS = 141440, LDS_BARST = 142464, LDS_PMLIST = 142480;

typedef __bf16 bf16x2_t __attribute__((ext_vector_type(2)));
__device__ __forceinline__ unsigned cvt_pk_bf16(float lo, float hi) { const bf16x2_t r = __builtin_convertvector((f32x2){lo, hi}, bf16x2_t); return __builtin_bit_cast(unsigned, r); }
__device__ __forceinline__ float bflo(unsigned u) { return __uint_as_float(u << 16); }
__device__ __forceinline__ float bfhi(unsigned u) { return __uint_as_float(u & 0xffff0000u); }
__device__ __forceinline__ float sigm(float z) { return __builtin_amdgcn_rcpf(1.f + __expf(-z)); }
__device__ __forceinline__ float rows_sum(float v) {
    float a = v, b = v; asm volatile("s_nop 1\n v_permlane16_swap_b32 %0, %1" : "+v"(a), "+v"(b)); const float s = a + b;
    float c = s, d = s; asm volatile("s_nop 1\n v_permlane32_swap_b32 %0, %1" : "+v"(c), "+v"(d)); return c + d;
}
__device__ __forceinline__ float wave_sum(float v) {
#pragma unroll
    for (int o = 1; o < 64; o <<= 1) v += __shfl_xor(v, o);
    return v;
}

struct Args { const float* in[18]; float* out; unsigned char* ws; };
enum { I_X = 0, I_C, I_GAIN, I_WMOD, I_BMOD, I_WIN, I_WOUT, I_CAW, I_SW, I_SB, I_LCW, I_LCB, I_WA, I_BA, I_WX, I_BX, I_LAM, I_FG, I_OUT, I_WS };
constexpr int PT_OFF = 131072 + 1024;
template <class T> __device__ __forceinline__ T* getp(LAS unsigned char* lds, int i) {
    int off = PT_OFF + 8 * i; asm volatile("" : "+v"(off));
    const u32x2 v = *(volatile LAS u32x2*)(lds + off);
    const unsigned lo = __builtin_amdgcn_readfirstlane(v.x), hi = __builtin_amdgcn_readfirstlane(v.y);
    return (T*)(__attribute__((address_space(1))) T*)(((unsigned long long)hi << 32) | (unsigned long long)lo);
}
__device__ __forceinline__ int launder(int v) { asm volatile("" : "+v"(v)); return v; }

namespace pg8 {
constexpr int BM = 256, BK = 64, HALF = 128, HTB = HALF * BK * 2, STAGE_BYTES = 8 * HTB, NXCD = 8, WGM = 8;
__host__ __device__ __forceinline__ int lds_byte(int r, int c) { const int st = (r >> 4) * 2 + (c >> 5), rr = r & 15, cc = c & 31, ob = rr * 64 + cc * 2; return st * 1024 + (ob ^ (((ob >> 9) & 1) << 5)); }
__host__ __device__ __forceinline__ void stage_rc(int b, int& R, int& C) { const int st = b / 1024, sb = b % 1024, swz = sb ^ (((sb >> 9) & 1) << 5); R = (st >> 1) * 16 + swz / 64; C = (st & 1) * 32 + (swz % 64) / 2; }

struct Unit { int pm, pn; };
struct Gemm { const bf16_t* A; const bf16_t* Bt; int M, N, K; };

struct StaticOrder {
    int nM, nN, nwg, G, c;
    __host__ __device__ __forceinline__ void init(int M_, int N_, int G_, int c_) { nM = M_ / BM; nN = N_ / BM; nwg = nM * nN; G = G_; c = c_; }
    __host__ __device__ __forceinline__ bool next(int i, Unit& u) const {
        const long L = (long)i * G + c; if (L >= nwg) return false;
        int wgid = (int)L; { const int q = nwg / NXCD, r = nwg % NXCD, xcd = wgid % NXCD, off = wgid / NXCD; wgid = (xcd < r ? xcd * (q + 1) : r * (q + 1) + (xcd - r) * q) + off; }
        const int nig = WGM * nN, gid = wgid / nig, fm = gid * WGM, gsz = (nM - fm) < WGM ? (nM - fm) : WGM;
        u.pm = fm + ((wgid % nig) % gsz); u.pn = (wgid % nig) / gsz; return true;
    }
};

template <class Epi, bool SEG, bool ALIGN_EPI = true, bool SP2 = true>
__device__ __forceinline__ void gemm_phase(LAS unsigned char* lds, const Gemm g, const StaticOrder& S, const Epi& E) {
    const int tid = launder(threadIdx.x), wid = __builtin_amdgcn_readfirstlane(tid >> 6), lane = tid & 63, wr = wid >> 2, wc = wid & 3, fr = lane & 15, fq = lane >> 4;
    const int K = g.K, nt = K / BK;
    unsigned voffA[2], voffB[2];
#pragma unroll
    for (int i = 0; i < 2; ++i) { int R, C; stage_rc(tid * 16 + i * 8192, R, C);
        const int Rb = SEG ? (((R >> 4) & 1) * 1024 + 16 * (R >> 5) + (R & 15)) : ((R & ~31) + 8 * ((R & 15) >> 2) + 4 * ((R >> 4) & 1) + (R & 3));
        voffA[i] = (unsigned)(R * K + C) * 2u; voffB[i] = (unsigned)(Rb * K + C) * 2u; }
    const size_t kstep = (size_t)(BK * 2);
    const size_t hstep = (size_t)HALF * K * 2;
    const size_t tstep = 2 * hstep;
    const size_t hstepB = SEG ? (size_t)2048 * K * 2 : hstep;
    const unsigned ldsw = (unsigned)wid * 1024u;
    const int aoff = lds_byte(wr * 64 + fr, fq * 8), boff = lds_byte(wc * 32 + fr, fq * 8);
#define PG8_BBASE(pn) (SEG ? ((size_t)(((pn) >> 4) * 4096 + ((pn) & 15) * 64) * K * 2) : ((size_t)(pn) * tstep))
#define PG8_SA(b, h) (((b) * 2 + (h)) * HTB)
#define PG8_SB(b, h) ((4 + (b) * 2 + (h)) * HTB)
#define PG8_STAGE(bufoff, gbase, voff) do { _Pragma("unroll") for (int _i = 0; _i < 2; ++_i) \
        __builtin_amdgcn_global_load_lds((const unsigned*)((const char*)(gbase) + (voff)[_i]), (LAS unsigned*)(lds + (bufoff) + ldsw + _i * 8192), 16, 0, 0); } while (0)
#define PG8_LDA(dst, b, h) do { _Pragma("unroll") for (int m = 0; m < 4; ++m) _Pragma("unroll") for (int k = 0; k < 2; ++k) dst[m][k] = *(const LAS bf16x8*)(lds + PG8_SA(b, h) + aoff + m * 2048 + k * 1024); } while (0)
#define PG8_LDB(dst, b, h) do { _Pragma("unroll") for (int n = 0; n < 2; ++n) _Pragma("unroll") for (int k = 0; k < 2; ++k) dst[n][k] = *(const LAS bf16x8*)(lds + PG8_SB(b, h) + boff + n * 2048 + k * 1024); } while (0)
#define PG8_MMA(ai, bj, At, Bt) do { __builtin_amdgcn_s_setprio(1); _Pragma("unroll") for (int m = 0; m < 4; ++m) _Pragma("unroll") for (int n = 0; n < 2; ++n) _Pragma("unroll") for (int k = 0; k < 2; ++k) \
        acc[ai][bj][m][n] = __builtin_amdgcn_mfma_f32_16x16x32_bf16(Bt[n][k], At[m][k], acc[ai][bj][m][n], 0, 0, 0); __builtin_amdgcn_s_setprio(0); } while (0)
#define PG8_WAIT_V(n) asm volatile("s_waitcnt vmcnt(" #n ")" ::: "memory")
#define PG8_WAIT_L(n) asm volatile("s_waitcnt lgkmcnt(" #n ")" ::: "memory")
#define PG8_BAR __builtin_amdgcn_s_barrier()
#define PG8_SCHED __builtin_amdgcn_sched_barrier(0)
    Unit cur, nxt; int ui = 0;
    if (!S.next(0, cur)) return;
    f32x4 acc[2][2][4][2];
#pragma unroll
    for (int a = 0; a < 2; ++a)
#pragma unroll
        for (int b = 0; b < 2; ++b)
#pragma unroll
            for (int m = 0; m < 4; ++m)
#pragma unroll
                for (int n = 0; n < 2; ++n) acc[a][b][m][n] = (f32x4){0.f, 0.f, 0.f, 0.f};
    bf16x8 At[4][2], B0[2][2], B1[2][2];
    const char* cA = (const char*)g.A + (size_t)cur.pm * tstep; const char* cB = (const char*)g.Bt + PG8_BBASE(cur.pn);
    if constexpr (SP2) {
        PG8_STAGE(PG8_SB(0, 0), cB, voffB); PG8_STAGE(PG8_SB(0, 1), cB + hstepB, voffB); PG8_STAGE(PG8_SA(0, 0), cA, voffA); PG8_STAGE(PG8_SA(0, 1), cA + hstep, voffA);
        if (wr == 1) PG8_BAR;
        PG8_WAIT_V(2); PG8_BAR;
        PG8_STAGE(PG8_SB(1, 0), cB + kstep, voffB); PG8_STAGE(PG8_SA(1, 0), cA + kstep, voffA); PG8_STAGE(PG8_SB(1, 1), cB + hstepB + kstep, voffB);
        PG8_WAIT_V(6); PG8_BAR;
    } else {
        PG8_STAGE(PG8_SB(0, 0), cB, voffB); PG8_STAGE(PG8_SA(0, 0), cA, voffA); PG8_STAGE(PG8_SB(0, 1), cB + hstepB, voffB); PG8_STAGE(PG8_SA(0, 1), cA + hstep, voffA);
        if (wr == 1) PG8_BAR;
        PG8_WAIT_V(4); PG8_BAR;
        PG8_STAGE(PG8_SB(1, 0), cB + kstep, voffB); PG8_STAGE(PG8_SA(1, 0), cA + kstep, voffA); PG8_STAGE(PG8_SB(1, 1), cB + hstepB + kstep, voffB);
        PG8_WAIT_V(6); PG8_BAR;
    }
    for (;;) {
        const bool has_next = S.next(ui + 1, nxt);
        const char* nA = has_next ? (const char*)g.A + (size_t)nxt.pm * tstep : cA; const char* nB = has_next ? (const char*)g.Bt + PG8_BBASE(nxt.pn) : cB;
        static_assert(SP2, "this build keeps only the two-super-phase K-loop");
#define PG8_KBODY(t, last) do { \
            const char* a1 = cA + (size_t)((t) + 1) * kstep; \
            const char* a2 = (last) ? nA : cA + (size_t)((t) + 2) * kstep; const char* b2 = (last) ? nB : cB + (size_t)((t) + 2) * kstep; \
            const char* a3 = a2 + kstep; const char* b3 = b2 + kstep; \
            PG8_LDB(B0, 0, 0); PG8_LDB(B1, 0, 1); PG8_SCHED; PG8_LDA(At, 0, 0); PG8_STAGE(PG8_SA(1, 1), a1 + hstep, voffA); \
            PG8_WAIT_V(8); PG8_WAIT_L(0); PG8_BAR; PG8_MMA(0, 0, At, B0); PG8_MMA(0, 1, At, B1); PG8_BAR; PG8_SCHED; \
            PG8_LDA(At, 0, 1); PG8_STAGE(PG8_SB(0, 0), b2, voffB); PG8_STAGE(PG8_SB(0, 1), b2 + hstepB, voffB); PG8_STAGE(PG8_SA(0, 0), a2, voffA); \
            PG8_WAIT_V(8); PG8_WAIT_L(0); PG8_BAR; PG8_MMA(1, 0, At, B0); PG8_MMA(1, 1, At, B1); PG8_BAR; PG8_SCHED; \
            PG8_LDB(B0, 1, 0); PG8_LDB(B1, 1, 1); PG8_SCHED; PG8_LDA(At, 1, 0); PG8_STAGE(PG8_SA(0, 1), a2 + hstep, voffA); \
            PG8_WAIT_V(8); PG8_WAIT_L(0); PG8_BAR; PG8_MMA(0, 0, At, B0); PG8_MMA(0, 1, At, B1); PG8_BAR; PG8_SCHED; \
            PG8_LDA(At, 1, 1); PG8_STAGE(PG8_SB(1, 0), b3, voffB); PG8_STAGE(PG8_SB(1, 1), b3 + hstepB, voffB); PG8_STAGE(PG8_SA(1, 0), a3, voffA); \
            PG8_WAIT_V(8); PG8_WAIT_L(0); PG8_BAR; PG8_MMA(1, 0, At, B0); PG8_MMA(1, 1, At, B1); PG8_BAR; PG8_SCHED; } while (0)
        for (int t = 0; t < nt; t += 2) { const bool last = (t == nt - 2);
            if (last) E.prefetch(cur, wid, lane);
            PG8_KBODY(t, last); }
#undef PG8_KBODY
        if constexpr (ALIGN_EPI) { if (wr == 0) PG8_BAR; }
        E(acc, cur, wr, wc, fr, fq);
        if (!has_next) break;
#pragma unroll
        for (int a = 0; a < 2; ++a)
#pragma unroll
            for (int b = 0; b < 2; ++b)
#pragma unroll
                for (int m = 0; m < 4; ++m)
#pragma unroll
                    for (int n = 0; n < 2; ++n) acc[a][b][m][n] = (f32x4){0.f, 0.f, 0.f, 0.f};
        cur = nxt; cA = nA; cB = nB; ++ui;
        if constexpr (ALIGN_EPI) { if (wr == 1) PG8_BAR; }
    }
    PG8_WAIT_V(0);
    if constexpr (!ALIGN_EPI) { if (wr == 0) PG8_BAR; }
    PG8_BAR;
#undef PG8_BBASE
#undef PG8_SA
#undef PG8_SB
#undef PG8_STAGE
#undef PG8_LDA
#undef PG8_LDB
#undef PG8_MMA
#undef PG8_WAIT_V
#undef PG8_WAIT_L
#undef PG8_BAR
#undef PG8_SCHED
}
}

struct EpiG1 {
    LAS unsigned char* lds; int l;
    __device__ __forceinline__ void prefetch(const pg8::Unit& u, int wid, int lane) const {
        if (wid == 0) { const float* bias = (const float*)(getp<unsigned char>(lds, I_WS) + WS_BIAS) + (size_t)l * 16 * NIN; lane = launder(lane);
            const float* src = bias + (size_t)(u.pm >> 3) * NIN + (u.pn >> 4) * 4096 + (u.pn & 15) * 64 + (lane >> 4) * 1024 + (lane & 15) * 4;
            __builtin_amdgcn_global_load_lds((const unsigned*)src, (LAS unsigned*)(lds + LDS_BIAS), 16, 0, 0); }
    }
    static __device__ __forceinline__ void rowswap(unsigned& x, unsigned& y) { asm volatile("s_nop 1\n v_permlane16_swap_b32 %0, %1" : "+v"(x), "+v"(y)); }
    template <int TT> __device__ __forceinline__ void body(const f32x4 (&acc)[2][2][4][2], const pg8::Unit& u, int wr, int wc, int fr_, int fq_) const {
        const int fr = launder(fr_), fq = launder(fq_);
        unsigned char* ws = getp<unsigned char>(lds, I_WS);
        const int cb = u.pn & 15;
        const int slot = __builtin_amdgcn_readfirstlane((int)*(const LAS unsigned char*)(lds + LDS_PMS + u.pm));
        const LAS float* rs = (const LAS float*)(lds + LDS_RSTD) + slot * 256 + wr * 64 + fr;
        const LAS float* bl = (const LAS float*)(lds + LDS_BIAS) + wc * 16 + fq * 4;
        const int par = fq & 1, hq = fq >> 1;
        bf16_t* Asel = (bf16_t*)(ws + (TT == 0 ? WS_P : TT == 1 ? WS_V : WS_XR) + (size_t)par * (64 * MiB));
        bf16_t* SGA = (bf16_t*)(ws + WS_SGA); float* VST = (float*)(ws + WS_VST);
        const f32x4 bs0 = *(const LAS f32x4*)bl, bs1 = *(const LAS f32x4*)(bl + 64), bs2 = *(const LAS f32x4*)(bl + 128), bs3 = *(const LAS f32x4*)(bl + 192);
        const int chblk = cb * 4 + wc;
#pragma unroll
        for (int ai = 0; ai < 2; ++ai) {
            const int rb0 = u.pm * 16 + ai * 8 + wr * 4;
            u32x2 sgprev = (u32x2){0u, 0u}; float smprev = 0.f, sqprev = 0.f;
#pragma unroll
            for (int m = 0; m < 4; ++m) {
                const float rstd = rs[ai * 128 + m * 16];
                const f32x4 s0 = acc[ai][0][m][0] * rstd + bs0, s1 = acc[ai][0][m][1] * rstd + bs1, s2 = acc[ai][1][m][0] * rstd + bs2, s3 = acc[ai][1][m][1] * rstd + bs3;
                u32x2 a0, a1;
                if constexpr (TT == 0) {
                    f32x4 p, q;
#pragma unroll
                    for (int e = 0; e < 4; ++e) { p[e] = s2[e] * s0[e]; q[e] = s3[e] * sigm(s3[e]) * s1[e]; }
                    a0 = (u32x2){cvt_pk_bf16(p[0], p[1]), cvt_pk_bf16(p[2], p[3])}; a1 = (u32x2){cvt_pk_bf16(q[0], q[1]), cvt_pk_bf16(q[2], q[3])};
                } else if constexpr (TT == 1) {
                    f32x4 q;
#pragma unroll
                    for (int e = 0; e < 4; ++e) q[e] = (s2[e] * s0[e]) * __builtin_amdgcn_rcpf((1.f + __expf(-s2[e])) * (1.f + __expf(-s3[e])));
                    a0 = (u32x2){cvt_pk_bf16(s1[0], s1[1]), cvt_pk_bf16(s1[2], s1[3])}; a1 = (u32x2){cvt_pk_bf16(q[0], q[1]), cvt_pk_bf16(q[2], q[3])};
                    const float smm = rows_sum((s1[0] + s1[1]) + (s1[2] + s1[3])), sqm = rows_sum((s1[0] * s1[0] + s1[1] * s1[1]) + (s1[2] * s1[2] + s1[3] * s1[3]));
                    if ((m & 1) == 0) { smprev = smm; sqprev = sqm; }
                    else if (hq == 0) {
                        *(f32x2*)(VST + ((((size_t)(rb0 + m - 1 + par) * 8 + (cb >> 1)) * 8 + (cb & 1) * 4 + wc) * 16 + fr) * 2) = par ? (f32x2){smm, sqm} : (f32x2){smprev, sqprev}; }
                } else {
                    f32x4 q, g;
#pragma unroll
                    for (int e = 0; e < 4; ++e) { q[e] = s1[e] * __builtin_amdgcn_rcpf((1.f + __expf(-s1[e])) * (1.f + __expf(-s2[e]))); g[e] = sigm(s3[e]); }
                    a0 = (u32x2){cvt_pk_bf16(s0[0], s0[1]), cvt_pk_bf16(s0[2], s0[3])}; a1 = (u32x2){cvt_pk_bf16(q[0], q[1]), cvt_pk_bf16(q[2], q[3])};
                    const u32x2 sgm = (u32x2){cvt_pk_bf16(g[0], g[1]), cvt_pk_bf16(g[2], g[3])};
                    if ((m & 1) == 0) sgprev = sgm;
                    else {
                        unsigned xx = sgprev.x, xy = sgprev.y, yx = sgm.x, yy = sgm.y; rowswap(xx, yx); rowswap(xy, yy);
                        const size_t so = ((size_t)((rb0 + m - 1 + par) * 64 + chblk)) * 256 + fr * 16 + 8 * hq;
                        __builtin_nontemporal_store((u32x4){xx, xy, yx, yy}, (u32x4*)(SGA + so)); }
                }
                unsigned a0x = a0.x, a0y = a0.y, a1x = a1.x, a1y = a1.y;
                rowswap(a0x, a1x); rowswap(a0y, a1y);
                const size_t off = ((size_t)((rb0 + m) * 64 + chblk)) * 256 + fr * 16 + 8 * hq;
                __builtin_nontemporal_store((u32x4){a0x, a0y, a1x, a1y}, (u32x4*)(Asel + off));
            }
        }
    }
    __device__ __forceinline__ void operator()(const f32x4 (&acc)[2][2][4][2], const pg8::Unit& u, int wr, int wc, int fr, int fq) const {
        const int tt = u.pn >> 4;
        if (tt == 0) body<0>(acc, u, wr, wc, fr, fq); else if (tt == 1) body<1>(acc, u, wr, wc, fr, fq); else body<2>(acc, u, wr, wc, fr, fq);
    }
};
struct EpiG2 {
    LAS unsigned char* lds; int l;
    __device__ __forceinline__ void prefetch(const pg8::Unit&, int, int) const {}
    __device__ __forceinline__ void operator()(const f32x4 (&acc)[2][2][4][2], const pg8::Unit& u, int wr, int wc, int fr_, int fq_) const {
        const int fr = launder(fr_), fq = launder(fq_);
        unsigned char* ws = getp<unsigned char>(lds, I_WS); float* xout = getp<float>(lds, I_OUT);
        const float* xin = (l == 0) ? getp<const float>(lds, I_X) : (const float*)xout;
        const float* gate = (const float*)(ws + WS_MOD) + (size_t)l * 16 * 3072 + 2048;
        const int do_next = l < DEPTH - 1 ? 1 : 0;
        const float* gp = (const float*)(ws + WS_GP) + (size_t)(do_next ? l + 1 : l) * 16 * D; bf16_t* H = (bf16_t*)(ws + WS_H); float* RSS = (float*)(ws + WS_RSS);
        const int b = u.pm >> 3, col0 = u.pn * 256 + wc * 32 + 8 * fq;
        f32x4 gv[2][2], pv[2][2];
#pragma unroll
        for (int bj = 0; bj < 2; ++bj)
#pragma unroll
            for (int n = 0; n < 2; ++n) { gv[bj][n] = *(const f32x4*)(gate + (size_t)b * 3072 + col0 + bj * 128 + n * 4);
                pv[bj][n] = *(const f32x4*)(gp + (size_t)b * D + col0 + bj * 128 + n * 4); }
#pragma unroll
        for (int ai = 0; ai < 2; ++ai)
#pragma unroll
            for (int m = 0; m < 4; ++m) {
                const int row = u.pm * 256 + ai * 128 + wr * 64 + m * 16 + fr;
                const size_t off = (size_t)row * D + col0;
                float ss = 0.f;
#pragma unroll
                for (int bj = 0; bj < 2; ++bj) {
                    const f32x4 x0 = *(const f32x4*)(xin + off + bj * 128), x1 = *(const f32x4*)(xin + off + bj * 128 + 4);
                    const f32x4 o0 = x0 + gv[bj][0] * acc[ai][bj][m][0], o1 = x1 + gv[bj][1] * acc[ai][bj][m][1];
                    *(f32x4*)(xout + off + bj * 128) = o0; *(f32x4*)(xout + off + bj * 128 + 4) = o1;
                    if (do_next) { ss += ((o0.x * o0.x + o0.y * o0.y) + (o0.z * o0.z + o0.w * o0.w)) + ((o1.x * o1.x + o1.y * o1.y) + (o1.z * o1.z + o1.w * o1.w));
                        const f32x4 h0 = o0 * pv[bj][0], h1 = o1 * pv[bj][1];
                        *(u32x4*)(H + off + bj * 128) = (u32x4){cvt_pk_bf16(h0.x, h0.y), cvt_pk_bf16(h0.z, h0.w), cvt_pk_bf16(h1.x, h1.y), cvt_pk_bf16(h1.z, h1.w)}; }
                }
                if (do_next) { ss = rows_sum(ss); if (fq == 0) RSS[(size_t)row * 16 + u.pn * 4 + wc] = ss; }
            }
    }
};

__device__ __forceinline__ void pm_slots_init(LAS unsigned char* lds, const pg8::StaticOrder& S) {
    const int tid = launder(threadIdx.x);
    LAS unsigned char* PMS = lds + LDS_PMS; LAS unsigned char* LIST = lds + LDS_PMLIST;
    if (tid < 128) PMS[tid] = (unsigned char)0xFF;
    __syncthreads();
    if (tid == 0) { int ns = 0; pg8::Unit u; for (int i = 0; S.next(i, u); ++i) if (PMS[u.pm] == 0xFF && ns < 8) { PMS[u.pm] = (unsigned char)ns; LIST[ns] = (unsigned char)u.pm; ++ns; } LIST[8] = (unsigned char)ns; }
    __syncthreads();
}
__device__ __forceinline__ void rstd_prelude(LAS unsigned char* lds, const float* RSS) {
    const int tid = launder(threadIdx.x);
    LAS unsigned char* LIST = lds + LDS_PMLIST; LAS float* RSTD = (LAS float*)(lds + LDS_RSTD);
    const int nslots = __builtin_amdgcn_readfirstlane((int)LIST[8]);
    for (int slot = 0; slot < nslots; ++slot) {
        const int pm = __builtin_amdgcn_readfirstlane((int)LIST[slot]);
        {   const int r = tid >> 1, hf = tid & 1; const f32x4* p = (const f32x4*)(RSS + (size_t)(pm * 256 + r) * 16 + hf * 8); const f32x4 a = p[0], c = p[1];
            float ss = ((a.x + a.y) + (a.z + a.w)) + ((c.x + c.y) + (c.z + c.w)); ss += __shfl_xor(ss, 1);
            if (hf == 0) RSTD[slot * 256 + r] = rsqrtf(ss * (1.f / D) + EPS); }
    }
    __syncthreads();
}

__device__ __forceinline__ void p0_transpose_item(const float* W, int K, int N, bf16_t* WT, int kb, int n0, int drow0, LAS float* scr, int lane) {
    const int k0 = 64 * kb;
    float tv[32];
#pragma unroll
    for (int i = 0; i < 32; ++i) tv[i] = W[(size_t)(k0 + 2 * i + (lane >> 5)) * N + n0 + (lane & 31)];
#pragma unroll
    for (int i = 0; i < 32; ++i) scr[(2 * i + (lane >> 5)) * 33 + (lane & 31)] = tv[i];
    asm volatile("s_waitcnt lgkmcnt(0)" ::: "memory");
    const int c = lane & 7;
#pragma unroll
    for (int j = 0; j < 4; ++j) { const int n = (lane >> 3) + 8 * j; const LAS float* s = scr + (8 * c) * 33 + n;
        u32x4 o; o.x = cvt_pk_bf16(s[0 * 33], s[1 * 33]); o.y = cvt_pk_bf16(s[2 * 33], s[3 * 33]); o.z = cvt_pk_bf16(s[4 * 33], s[5 * 33]); o.w = cvt_pk_bf16(s[6 * 33], s[7 * 33]);
        *(u32x4*)(WT + (size_t)(drow0 + n) * K + k0 + 8 * c) = o; }
    asm volatile("s_waitcnt lgkmcnt(0)" ::: "memory");
}

__device__ __forceinline__ void p0_prologue(LAS unsigned char* lds) {
    const int tid = launder(threadIdx.x), wid = tid >> 6, lane = tid & 63, G = gridDim.x;
    unsigned char* ws = getp<unsigned char>(lds, I_WS);
    const float* in_c = getp<const float>(lds, I_C); const float* in_wmod = getp<const float>(lds, I_WMOD); const float* in_bmod = getp<const float>(lds, I_BMOD);
    {
        LAS float* CA = (LAS float*)lds; LAS float* RED = (LAS float*)(lds + 65536);
        float* MOD = (float*)(ws + WS_MOD);
        for (int u = blockIdx.x; u < 192; u += G) {
            __syncthreads();
            for (int i = tid; i < NB * D; i += 512) { const float v = in_c[i]; CA[i] = v * sigm(v); }
            __syncthreads();
            const int l = u / 48, j0 = (u % 48) * 64;
            const float* wp = in_wmod + (size_t)l * D * 3072 + j0 + lane;
            float acc[16];
#pragma unroll
            for (int b = 0; b < 16; ++b) acc[b] = 0.f;
            for (int k = 128 * wid; k < 128 * wid + 128; k += 16) {
                float wv[16];
#pragma unroll
                for (int q = 0; q < 16; ++q) wv[q] = wp[(size_t)(k + q) * 3072];
#pragma unroll
                for (int q = 0; q < 16; q += 4)
#pragma unroll
                    for (int b = 0; b < 16; ++b) { const f32x4 cv = *(const LAS f32x4*)(CA + b * D + k + q); acc[b] += (cv.x * wv[q] + cv.y * wv[q + 1]) + (cv.z * wv[q + 2] + cv.w * wv[q + 3]); }
            }
#pragma unroll
            for (int b = 0; b < 16; ++b) RED[(wid * 16 + b) * 64 + lane] = acc[b];
            __syncthreads();
            for (int o = tid; o < 1024; o += 512) { const int b = o >> 6, ci = o & 63; float s = in_bmod[l * 3072 + j0 + ci];
#pragma unroll
                for (int w = 0; w < 8; ++w) s += RED[(w * 16 + b) * 64 + ci];
                MOD[(size_t)(l * 16 + b) * 3072 + j0 + ci] = s; }
        }
        __syncthreads();
    }
    {
        LAS float* scr = (LAS float*)(lds + wid * 16384);
        const int gw = blockIdx.x * 8 + wid, NGW = G * 8;
        const float* in_win = getp<const float>(lds, I_WIN); const float* in_wout = getp<const float>(lds, I_WOUT);
        constexpr int I_IN = 16 * 384, I_OUT = 16 * 32, I_L = I_IN + I_OUT;
        for (int it = gw; it < DEPTH * I_L; it += NGW) {
            const int l = it / I_L; int r = it % I_L;
            if (r < I_IN) { const int kb = r / 384, nb = r % 384, n0 = nb * 32, sseg = n0 >> 10;
                const int dseg = (int)((0xA7B986543210ULL >> (4 * sseg)) & 15ULL);
                p0_transpose_item(in_win + (size_t)l * D * NIN, D, NIN, (bf16_t*)(ws + WS_WIN) + (size_t)l * NIN * D, kb, n0, dseg * 1024 + (n0 & 1023), scr, lane);
            } else { r -= I_IN; const int kb = r / 32, nb = r % 32;
                p0_transpose_item(in_wout + (size_t)l * D * D, D, D, (bf16_t*)(ws + WS_WOUT) + (size_t)l * D * D, kb, nb * 32, nb * 32, scr, lane); }
        }
    }
    {
        const int gt = blockIdx.x * 512 + tid, NT = G * 512;
        const float* in_sw = getp<const float>(lds, I_SW); const float* in_wa = getp<const float>(lds, I_WA); const float* in_wx = getp<const float>(lds, I_WX);
        bf16_t* WSB = (bf16_t*)(ws + WS_WSB);
        for (int i = gt; i < DEPTH * 8 * 128 * 128 / 2; i += NT) { const int e0 = 2 * i, t = (e0 >> 7) & 127, s = e0 & 127; const f32x2 v = *(const f32x2*)(in_sw + e0);
            *(unsigned*)(WSB + e0) = cvt_pk_bf16(s <= t ? v.x : 0.f, (s + 1) <= t ? v.y : 0.f); }
        bf16_t* WA = (bf16_t*)(ws + WS_WA); bf16_t* WX = (bf16_t*)(ws + WS_WX);
        for (int i = gt; i < DEPTH * 16 * 64 * 64; i += NT) { const int d = i & 63, e = (i >> 6) & 63, lh = i >> 12;
            const float va = in_wa[(size_t)lh * 4096 + d * 64 + e], vx = in_wx[(size_t)lh * 4096 + d * 64 + e];
            WA[i] = (bf16_t)(cvt_pk_bf16(va, 0.f) & 0xffffu); WX[i] = (bf16_t)(cvt_pk_bf16(vx, 0.f) & 0xffffu); }
    }
}

__device__ __forceinline__ void p1_prologue(LAS unsigned char* lds) {
    const int tid = launder(threadIdx.x), wid = tid >> 6, lane = tid & 63, G = gridDim.x;
    unsigned char* ws = getp<unsigned char>(lds, I_WS);
    const float* MOD = (const float*)(ws + WS_MOD);
    {   const int gt = blockIdx.x * 512 + tid, NT = G * 512; const float* gain = getp<const float>(lds, I_GAIN); float* GP = (float*)(ws + WS_GP);
        for (int i = gt; i < DEPTH * NB * D; i += NT) { const int l = i >> 14, b = (i >> 10) & 15, col = i & 1023; GP[i] = gain[l * D + col] * (1.f + MOD[(size_t)(l * 16 + b) * 3072 + 1024 + col]); } }
    {   const float* xin = getp<const float>(lds, I_X); const float* gain = getp<const float>(lds, I_GAIN); bf16_t* H = (bf16_t*)(ws + WS_H); float* RSS = (float*)(ws + WS_RSS);
        const int gw = blockIdx.x * 8 + wid, NGW = G * 8;
        for (int row = gw; row < M; row += NGW) {
            const int b = row >> 11;
            const f32x4* xr = (const f32x4*)(xin + (size_t)row * D) + lane;
            f32x4 v[4]; float ss = 0.f;
#pragma unroll
            for (int j = 0; j < 4; ++j) { v[j] = xr[64 * j]; ss += (v[j].x * v[j].x + v[j].y * v[j].y) + (v[j].z * v[j].z + v[j].w * v[j].w); }
            ss = wave_sum(ss);
            if (lane < 16) RSS[(size_t)row * 16 + lane] = lane == 0 ? ss : 0.f;
#pragma unroll
            for (int j = 0; j < 4; ++j) { const int col = 4 * lane + 256 * j;
                const f32x4 g = *(const f32x4*)(gain + col), sc = *(const f32x4*)(MOD + (size_t)b * 3072 + 1024 + col);
                const f32x4 o = v[j] * g * (sc + 1.f);
                *(u32x2*)(H + (size_t)row * D + col) = (u32x2){cvt_pk_bf16(o.x, o.y), cvt_pk_bf16(o.z, o.w)}; }
        }
    }
    {
        float* BIAS = (float*)(ws + WS_BIAS); const bf16_t* WT = (const bf16_t*)(ws + WS_WIN);
        const int gw = blockIdx.x * 8 + wid, NGW = G * 8, fr = lane & 15, fq = lane >> 4;
        for (int it = gw; it < DEPTH * (NIN / 16); it += NGW) {
            const int l = it / (NIN / 16), n0 = (it % (NIN / 16)) * 16;
            const bf16_t* wrow = WT + ((size_t)l * NIN + n0 + fr) * D + 8 * fq;
            const float* srow = MOD + (size_t)(l * 16 + fr) * 3072 + 8 * fq;
            f32x4 acc = (f32x4){0.f, 0.f, 0.f, 0.f};
#pragma unroll 8
            for (int ks = 0; ks < 32; ++ks) {
                const bf16x8 bfrag = *(const bf16x8*)(wrow + 32 * ks);
                const f32x4 s0 = *(const f32x4*)(srow + 32 * ks), s1 = *(const f32x4*)(srow + 32 * ks + 4);
                const u32x4 ap = (u32x4){cvt_pk_bf16(s0.x, s0.y), cvt_pk_bf16(s0.z, s0.w), cvt_pk_bf16(s1.x, s1.y), cvt_pk_bf16(s1.z, s1.w)};
                acc = __builtin_amdgcn_mfma_f32_16x16x32_bf16(__builtin_bit_cast(bf16x8, ap), bfrag, acc, 0, 0, 0);
            }
#pragma unroll
            for (int e = 0; e < 4; ++e) BIAS[(size_t)(l * 16 + 4 * fq + e) * NIN + n0 + fr] = acc[e];
        }
    }
}

__device__ __forceinline__ void norm_phase(const float* xin, bf16_t* H, const float* gain, const float* modl) {
    const int tid = launder(threadIdx.x), wid = tid >> 6, lane = tid & 63;
    const int gw = blockIdx.x * 8 + wid, NGW = gridDim.x * 8;
    for (int row = gw; row < M; row += NGW) {
        const int b = row >> 11;
        const f32x4* xr = (const f32x4*)(xin + (size_t)row * D) + lane;
        f32x4 v[4]; float ss = 0.f;
#pragma unroll
        for (int j = 0; j < 4; ++j) { v[j] = xr[64 * j]; ss += (v[j].x * v[j].x + v[j].y * v[j].y) + (v[j].z * v[j].z + v[j].w * v[j].w); }
        const float rstd = rsqrtf(wave_sum(ss) * (1.f / D) + EPS);
#pragma unroll
        for (int j = 0; j < 4; ++j) { const int col = 4 * lane + 256 * j;
            const f32x4 g = *(const f32x4*)(gain + col), sh = *(const f32x4*)(modl + (size_t)b * 3072 + col), sc = *(const f32x4*)(modl + (size_t)b * 3072 + 1024 + col);
            const f32x4 o = v[j] * rstd * g * (sc + 1.f) + sh;
            *(u32x2*)(H + (size_t)row * D + col) = (u32x2){cvt_pk_bf16(o.x, o.y), cvt_pk_bf16(o.z, o.w)}; }
    }
}
__device__ __forceinline__ void final_norm(float* x, const float* gain) {
    const int tid = launder(threadIdx.x), wid = tid >> 6, lane = tid & 63;
    const int gw = blockIdx.x * 8 + wid, NGW = gridDim.x * 8;
    for (int row = gw; row < M; row += NGW) {
        f32x4* xr = (f32x4*)(x + (size_t)row * D) + lane;
        f32x4 v[4]; float ss = 0.f;
#pragma unroll
        for (int j = 0; j < 4; ++j) { v[j] = xr[64 * j]; ss += (v[j].x * v[j].x + v[j].y * v[j].y) + (v[j].z * v[j].z + v[j].w * v[j].w); }
        const float rstd = rsqrtf(wave_sum(ss) * (1.f / D) + EPS);
#pragma unroll
        for (int j = 0; j < 4; ++j) { const f32x4 g = *(const f32x4*)(gain + 4 * lane + 256 * j); xr[64 * j] = v[j] * rstd * g; }
    }
}

struct U8 { u32x4 a, b; };
__device__ __forceinline__ U8 ld16(const bf16_t* p, bool ok) { U8 r; if (ok) { r.a = *(const u32x4*)p; r.b = *(const u32x4*)(p + 8); } else { r.a = (u32x4){0u, 0u, 0u, 0u}; r.b = r.a; } return r; }
__device__ __forceinline__ void unpack16(const U8& u, float (&o)[16]) {
    o[0] = bflo(u.a.x); o[1] = bfhi(u.a.x); o[2] = bflo(u.a.y); o[3] = bfhi(u.a.y); o[4] = bflo(u.a.z); o[5] = bfhi(u.a.z); o[6] = bflo(u.a.w); o[7] = bfhi(u.a.w);
    o[8] = bflo(u.b.x); o[9] = bfhi(u.b.x); o[10] = bflo(u.b.y); o[11] = bfhi(u.b.y); o[12] = bflo(u.b.z); o[13] = bfhi(u.b.z); o[14] = bflo(u.b.w); o[15] = bfhi(u.b.w);
}
template <int N> __device__ __forceinline__ float dpp_shr(float v, float ident) {
    return __builtin_bit_cast(float, __builtin_amdgcn_update_dpp(__builtin_bit_cast(int, ident), __builtin_bit_cast(int, v), 0x110 + N, 0xf, 0xf, false));
}
template <int N> __device__ __forceinline__ unsigned dppi(unsigned v, unsigned old) { return (unsigned)__builtin_amdgcn_update_dpp((int)old, (int)v, 0x110 + N, 0xf, 0xf, false); }
template <int N> __device__ __forceinline__ U8 shr_rows(const U8& cur, const U8& halo) { U8 r;
    r.a.x = dppi<N>(cur.a.x, halo.a.x); r.a.y = dppi<N>(cur.a.y, halo.a.y); r.a.z = dppi<N>(cur.a.z, halo.a.z); r.a.w = dppi<N>(cur.a.w, halo.a.w);
    r.b.x = dppi<N>(cur.b.x, halo.b.x); r.b.y = dppi<N>(cur.b.y, halo.b.y); r.b.z = dppi<N>(cur.b.z, halo.b.z); r.b.w = dppi<N>(cur.b.w, halo.b.w); return r; }
template <int N> __device__ __forceinline__ float row_bcast(float v) { return __builtin_bit_cast(float, __builtin_amdgcn_update_dpp(0, __builtin_bit_cast(int, v), 0x150 + N, 0xf, 0xf, true)); }
template <int N> __device__ __forceinline__ float fmac_bc(float acc, float k, float x) { asm("v_fmac_f32_dpp %0, %1, %2 row_newbcast:%3 row_mask:0xf bank_mask:0xf" : "+v"(acc) : "v"(k), "v"(x), "n"(N)); return acc; }
template <int N> __device__ __forceinline__ float mul_bc(float k, float x) { float r; asm("v_mul_f32_dpp %0, %1, %2 row_newbcast:%3 row_mask:0xf bank_mask:0xf" : "=v"(r) : "v"(k), "v"(x), "n"(N)); return r; }
template <int N> __device__ __forceinline__ u32x4 shr4(const u32x4 cur, const u32x4 halo) { u32x4 r; r.x = dppi<N>(cur.x, halo.x); r.y = dppi<N>(cur.y, halo.y); r.z = dppi<N>(cur.z, halo.z); r.w = dppi<N>(cur.w, halo.w); return r; }
__device__ __forceinline__ void unpack8(const u32x4 u, float (&o)[8]) { o[0] = bflo(u.x); o[1] = bfhi(u.x); o[2] = bflo(u.y); o[3] = bfhi(u.y); o[4] = bflo(u.z); o[5] = bfhi(u.z); o[6] = bflo(u.w); o[7] = bfhi(u.w); }
__device__ __forceinline__ U8 lds16(const LAS unsigned char* p) { U8 r; r.a = *(const LAS u32x4*)p; r.b = *(const LAS u32x4*)(p + 16); return r; }
#define SCAN8(N, o) asm volatile("s_nop 1\n" \
    "v_fmac_f32_dpp %8, %8, %0 row_shr:" #N " row_mask:0xf bank_mask:0xf\n v_fmac_f32_dpp %9, %9, %1 row_shr:" #N " row_mask:0xf bank_mask:0xf\n" \
    "v_fmac_f32_dpp %10, %10, %2 row_shr:" #N " row_mask:0xf bank_mask:0xf\n v_fmac_f32_dpp %11, %11, %3 row_shr:" #N " row_mask:0xf bank_mask:0xf\n" \
    "v_fmac_f32_dpp %12, %12, %4 row_shr:" #N " row_mask:0xf bank_mask:0xf\n v_fmac_f32_dpp %13, %13, %5 row_shr:" #N " row_mask:0xf bank_mask:0xf\n" \
    "v_fmac_f32_dpp %14, %14, %6 row_shr:" #N " row_mask:0xf bank_mask:0xf\n v_fmac_f32_dpp %15, %15, %7 row_shr:" #N " row_mask:0xf bank_mask:0xf\n" \
    "v_mul_f32_dpp %0, %0, %0 row_shr:" #N " row_mask:0xf bank_mask:0xf\n v_mul_f32_dpp %1, %1, %1 row_shr:" #N " row_mask:0xf bank_mask:0xf\n" \
    "v_mul_f32_dpp %2, %2, %2 row_shr:" #N " row_mask:0xf bank_mask:0xf\n v_mul_f32_dpp %3, %3, %3 row_shr:" #N " row_mask:0xf bank_mask:0xf\n" \
    "v_mul_f32_dpp %4, %4, %4 row_shr:" #N " row_mask:0xf bank_mask:0xf\n v_mul_f32_dpp %5, %5, %5 row_shr:" #N " row_mask:0xf bank_mask:0xf\n" \
    "v_mul_f32_dpp %6, %6, %6 row_shr:" #N " row_mask:0xf bank_mask:0xf\n v_mul_f32_dpp %7, %7, %7 row_shr:" #N " row_mask:0xf bank_mask:0xf\n" \
    : "+v"(av[o + 0]), "+v"(av[o + 1]), "+v"(av[o + 2]), "+v"(av[o + 3]), "+v"(av[o + 4]), "+v"(av[o + 5]), "+v"(av[o + 6]), "+v"(av[o + 7]), \
      "+v"(bv[o + 0]), "+v"(bv[o + 1]), "+v"(bv[o + 2]), "+v"(bv[o + 3]), "+v"(bv[o + 4]), "+v"(bv[o + 5]), "+v"(bv[o + 6]), "+v"(bv[o + 7]))
#define SCAN_STEP(N) do { SCAN8(N, 0); SCAN8(N, 8); } while (0)

constexpr int MX_VNT = 0, MX_XC = 17408, MX_WAT = 35840, MX_WXT = 45056, MX_PRM = 54272, MX_STAT = 57344, MX_SEG = 59392, MX_HIN = 63488, MX_CARRY = 65536, MX_WS = 66048, MX_PH = 100864, MX_XH = 107776;

__device__ __forceinline__ void mixer_fill(LAS unsigned char* lds, int l, int u) {
    const int tid = launder(threadIdx.x);
    unsigned char* ws = getp<unsigned char>(lds, I_WS);
    const int j = u & 15, hh = j >> 1;
    LAS unsigned char* WAT = lds + MX_WAT; LAS unsigned char* WXT = lds + MX_WXT; LAS float* PRM = (LAS float*)(lds + MX_PRM); LAS float* CARRY = (LAS float*)(lds + MX_CARRY);
        {   const int e = tid >> 3, d0 = (tid & 7) * 8;
        const size_t wo = ((size_t)(l * 16 + j) * 64 + e) * 64 + d0;
        *(LAS u32x4*)(WAT + e * 144 + d0 * 2) = *(const u32x4*)((const bf16_t*)(ws + WS_WA) + wo);
        *(LAS u32x4*)(WXT + e * 144 + d0 * 2) = *(const u32x4*)((const bf16_t*)(ws + WS_WX) + wo); }
    for (int i = tid; i < 11 * 64; i += 512) { const int r = i >> 6, ch = 64 * j + (i & 63); float v;
        if (r < 3) v = getp<const float>(lds, I_CAW)[(l * 3 + r) * D + ch];
        else if (r < 7) v = getp<const float>(lds, I_LCW)[(l * 4 + (r - 3)) * D + ch];
        else if (r == 7) v = getp<const float>(lds, I_LCB)[l * D + ch];
        else if (r == 8) v = getp<const float>(lds, I_BA)[l * D + ch];
        else if (r == 9) v = getp<const float>(lds, I_BX)[l * D + ch];
        else v = -8.f * log1pf(expf(-getp<const float>(lds, I_LAM)[l * D + ch]));
        PRM[i] = v; }
    if (tid < 128) CARRY[tid] = 0.f;
    if (tid < 96) { *(LAS unsigned*)(lds + MX_PH + 4 * tid) = 0u; *(LAS unsigned*)(lds + MX_XH + 4 * tid) = 0u; }
#pragma unroll
    for (int i = 0; i < 4; ++i) { const int q = tid + 512 * i, row = q >> 4, c16 = q & 15;
        *(LAS u32x4*)(lds + MX_WS + row * 272 + c16 * 16) = *(const u32x4*)((const bf16_t*)(ws + WS_WSB) + ((size_t)((l * 8 + hh) * 128 + row)) * 128 + c16 * 8); }
}

__device__ __forceinline__ void mixer_phase(LAS unsigned char* lds, int l) {
    const int tid0 = launder(threadIdx.x), wid = __builtin_amdgcn_readfirstlane(tid0 >> 6);
    unsigned char* ws = getp<unsigned char>(lds, I_WS);
    const bf16_t* P = (const bf16_t*)(ws + WS_P); const bf16_t* QA = (const bf16_t*)(ws + WS_QA); const bf16_t* V = (const bf16_t*)(ws + WS_V); const bf16_t* QS = (const bf16_t*)(ws + WS_QS);
    const bf16_t* XR = (const bf16_t*)(ws + WS_XR); const bf16_t* QR = (const bf16_t*)(ws + WS_QR); const bf16_t* SGA = (const bf16_t*)(ws + WS_SGA);
    const float* VST = (const float*)(ws + WS_VST); bf16_t* MRG = (bf16_t*)(ws + WS_MRG);
    LAS unsigned char* VNT = lds + MX_VNT; LAS unsigned char* XC = lds + MX_XC; LAS unsigned char* WAT = lds + MX_WAT; LAS unsigned char* WXT = lds + MX_WXT;
    LAS float* PRM = (LAS float*)(lds + MX_PRM); LAS f32x2* STAT = (LAS f32x2*)(lds + MX_STAT); LAS f32x2* SEG = (LAS f32x2*)(lds + MX_SEG);
    LAS float* HIN = (LAS float*)(lds + MX_HIN); LAS float* CARRY = (LAS float*)(lds + MX_CARRY);
    for (int u0 = blockIdx.x; u0 < 256; u0 += gridDim.x) {
        int u = u0; asm volatile("" : "+s"(u));
        const int b = u >> 4, j = u & 15, hh = j >> 1;
        const int tid = launder(tid0), lane0 = tid & 63, fr = lane0 & 15;
        __syncthreads();
        if (u0 != (int)blockIdx.x) mixer_fill(lds, l, u);
        const float bsv = getp<const float>(lds, I_SB)[(l * 8 + hh) * 128 + 16 * wid + fr];
        float kR[5], kA[3];
        __syncthreads();
#pragma unroll
        for (int r = 0; r < 5; ++r) kR[r] = PRM[(3 + r) * 64 + lane0];
#pragma unroll
        for (int r = 0; r < 3; ++r) kA[r] = PRM[r * 64 + lane0];
        bf16x8 waf[4][2];
#pragma unroll
        for (int nt = 0; nt < 4; ++nt)
#pragma unroll
            for (int ks = 0; ks < 2; ++ks) waf[nt][ks] = *(const LAS bf16x8*)(WAT + (16 * ((lane0 & 15) >> 2) + (lane0 & 3) + 4 * nt) * 144 + (32 * ks + 8 * (lane0 >> 4)) * 2);
        bf16x8 wsf[4];
#pragma unroll
        for (int ks = 0; ks < 4; ++ks) wsf[ks] = *(const LAS bf16x8*)(lds + MX_WS + (16 * wid + fr) * 272 + (32 * ks + 8 * (lane0 >> 4)) * 2);
        unsigned cV[8], nV[8]; U8 cP, cX, nP, nX; f32x4 nS;
        {   const int lane = launder(lane0), fr = lane & 15, fq = lane >> 4, tid = wid * 64 + lane, R = tid >> 5, C = tid & 31;
            const int r0 = b * SEQ; const unsigned eoff = (unsigned)((((r0 >> 4) + wid) * 64 + 4 * j + fq) * 256 + fr * 16);
#pragma unroll
            for (int i = 0; i < 8; ++i) cV[i] = *(const unsigned*)(V + (unsigned)((((r0 >> 4) + (R >> 1)) * 64 + 4 * j + (C >> 3)) * 256 + (8 * (R & 1) + i) * 16 + 2 * (C & 7)));
            cP = ld16(P + eoff, true); cX = ld16(XR + eoff, true);
            {   const unsigned so = (unsigned)((((((r0 + (tid >> 2)) >> 4) * 8 + hh) * 8 + 2 * (tid & 3)) * 16 + ((tid >> 2) & 15)) * 2);
                const f32x2 sa = *(const f32x2*)(VST + so), sb = *(const f32x2*)(VST + so + 32); const f32x4 sv = (f32x4){sa.x, sa.y, sb.x, sb.y};
                float sm = sv.x + sv.z, sq = sv.y + sv.w; sm += __shfl_xor(sm, 1); sq += __shfl_xor(sq, 1); sm += __shfl_xor(sm, 2); sq += __shfl_xor(sq, 2);
                const float mean = sm * (1.f / 128.f), var = fmaxf(sq * (1.f / 128.f) - mean * mean, 0.f); if ((tid & 3) == 0) STAT[tid >> 2] = (f32x2){mean, rsqrtf(var + EPS)}; }
            if (fr >= 13 && wid < 7) { LAS unsigned char* hp = lds + MX_PH + ((wid + 1) * 3 + (fr - 13)) * 128 + 32 * fq; LAS unsigned char* hx = hp + (MX_XH - MX_PH);
                *(LAS u32x4*)hp = cP.a; *(LAS u32x4*)(hp + 16) = cP.b; *(LAS u32x4*)hx = cX.a; *(LAS u32x4*)(hx + 16) = cX.b; }
        }
        __syncthreads();
        for (int c = 0; c < 16; ++c) {
            const int lane = launder(lane0), fr = lane & 15, fq = lane >> 4, tid = wid * 64 + lane;
            const int r0 = b * SEQ + c * 128, trow = 16 * wid + fr;
            const unsigned moff = (unsigned)((r0 + trow) * D + 64 * j + 16 * fq);
            const unsigned eoff = (unsigned)((((r0 >> 4) + wid) * 64 + 4 * j + fq) * 256 + fr * 16);
            const int R = tid >> 5, C = tid & 31;
            const int par = c & 1; const bool more = c < 15;
            const U8 cQA = ld16(QA + eoff, true), cSG = ld16(SGA + eoff, true);
            if (wid == 7 && fr >= 13) {
                LAS unsigned char* hp = lds + MX_PH + (((par ^ 1) * 9) * 3 + (fr - 13)) * 128 + 32 * fq; LAS unsigned char* hx = hp + (MX_XH - MX_PH);
                *(LAS u32x4*)hp = cP.a; *(LAS u32x4*)(hp + 16) = cP.b; *(LAS u32x4*)hx = cX.a; *(LAS u32x4*)(hx + 16) = cX.b; }
            {   float lo[8], hi[8];
#pragma unroll
                for (int i = 0; i < 8; ++i) { const f32x2 st = STAT[par * 128 + 8 * R + i]; lo[i] = (bflo(cV[i]) - st.x) * st.y; hi[i] = (bfhi(cV[i]) - st.x) * st.y; }
                *(LAS u32x4*)(VNT + (2 * C) * 272 + 16 * R) = (u32x4){cvt_pk_bf16(lo[0], lo[1]), cvt_pk_bf16(lo[2], lo[3]), cvt_pk_bf16(lo[4], lo[5]), cvt_pk_bf16(lo[6], lo[7])};
                *(LAS u32x4*)(VNT + (2 * C + 1) * 272 + 16 * R) = (u32x4){cvt_pk_bf16(hi[0], hi[1]), cvt_pk_bf16(hi[2], hi[3]), cvt_pk_bf16(hi[4], hi[5]), cvt_pk_bf16(hi[6], hi[7])};
            }
            float outv[16], xc[16];
            const LAS unsigned char* hbase = lds + MX_PH + (par * 9 + wid) * 384 + 32 * fq;
#pragma unroll
            for (int hf = 0; hf < 2; ++hf) {
                float x0[8], x1[8], x2[8], x3[8];
                {   const LAS unsigned char* hx = hbase + (MX_XH - MX_PH) + 16 * hf; const u32x4 cx = hf ? cX.b : cX.a;
                    u32x4 h1 = (u32x4){0u, 0u, 0u, 0u}, h2 = h1, h3 = h1;
                    if (fr < 3) { h1 = *(const LAS u32x4*)(hx + 2 * 128); h2 = *(const LAS u32x4*)(hx + min(1 + fr, 2) * 128); h3 = *(const LAS u32x4*)(hx + fr * 128); }
                    unpack8(shr4<1>(cx, h1), x1); unpack8(shr4<2>(cx, h2), x2); unpack8(shr4<3>(cx, h3), x3); unpack8(cx, x0); }
#define CONVR(i) xc[8 * hf + i] = fmac_bc<8 * HF + i>(fmac_bc<8 * HF + i>(fmac_bc<8 * HF + i>(fmac_bc<8 * HF + i>(row_bcast<8 * HF + i>(kR[4]), kR[0], x3[i]), kR[1], x2[i]), kR[2], x1[i]), kR[3], x0[i])
                if (hf == 0) { constexpr int HF = 0; CONVR(0); CONVR(1); CONVR(2); CONVR(3); CONVR(4); CONVR(5); CONVR(6); CONVR(7); }
                else { constexpr int HF = 1; CONVR(0); CONVR(1); CONVR(2); CONVR(3); CONVR(4); CONVR(5); CONVR(6); CONVR(7); }
#undef CONVR
                *(LAS u32x4*)(XC + trow * 144 + 32 * fq + 16 * hf) = (u32x4){cvt_pk_bf16(xc[8 * hf + 0], xc[8 * hf + 1]), cvt_pk_bf16(xc[8 * hf + 2], xc[8 * hf + 3]), cvt_pk_bf16(xc[8 * hf + 4], xc[8 * hf + 5]), cvt_pk_bf16(xc[8 * hf + 6], xc[8 * hf + 7])};
            }
#pragma unroll
            for (int hf = 0; hf < 2; ++hf) {
                float p0[8], p1[8], p2[8], qa[8], sg[8];
                {   const u32x4 cp = hf ? cP.b : cP.a;
                    u32x4 h1 = (u32x4){0u, 0u, 0u, 0u}, h2 = h1;
                    if (fr < 2) { h1 = *(const LAS u32x4*)(hbase + 2 * 128 + 16 * hf); h2 = *(const LAS u32x4*)(hbase + (1 + fr) * 128 + 16 * hf); }
                    unpack8(shr4<1>(cp, h1), p1); unpack8(shr4<2>(cp, h2), p2); unpack8(cp, p0); unpack8(hf ? cQA.b : cQA.a, qa); unpack8(hf ? cSG.b : cSG.a, sg); }
#define CONVA(i) outv[8 * hf + i] = sg[i] * qa[i] * fmac_bc<8 * HF + i>(fmac_bc<8 * HF + i>(mul_bc<8 * HF + i>(kA[0], p2[i]), kA[1], p1[i]), kA[2], p0[i])
                if (hf == 0) { constexpr int HF = 0; CONVA(0); CONVA(1); CONVA(2); CONVA(3); CONVA(4); CONVA(5); CONVA(6); CONVA(7); }
                else { constexpr int HF = 1; CONVA(0); CONVA(1); CONVA(2); CONVA(3); CONVA(4); CONVA(5); CONVA(6); CONVA(7); }
#undef CONVA
            }
            const U8 cQS = ld16(QS + eoff, true), cQR = ld16(QR + eoff, true);
            {
                const int rn = more ? r0 + 128 : r0; const unsigned noff = (unsigned)((((rn >> 4) + wid) * 64 + 4 * j + fq) * 256 + fr * 16);
#pragma unroll
                for (int i = 0; i < 8; ++i) nV[i] = *(const unsigned*)(V + (unsigned)((((rn >> 4) + (R >> 1)) * 64 + 4 * j + (C >> 3)) * 256 + (8 * (R & 1) + i) * 16 + 2 * (C & 7)));
                nP = ld16(P + noff, true); nX = ld16(XR + noff, true);
                {   const unsigned so = (unsigned)((((((rn + (tid >> 2)) >> 4) * 8 + hh) * 8 + 2 * (tid & 3)) * 16 + ((tid >> 2) & 15)) * 2);
                    const f32x2 sa = *(const f32x2*)(VST + so), sb = *(const f32x2*)(VST + so + 32); nS = (f32x4){sa.x, sa.y, sb.x, sb.y}; }
            }
            float av[16], bv[16];
            {   bf16x8 xcf[2];
#pragma unroll
                for (int ks = 0; ks < 2; ++ks) xcf[ks] = *(const LAS bf16x8*)(XC + trow * 144 + (32 * ks + 8 * fq) * 2);
                const int erow = 16 * (fr >> 2) + (fr & 3);
#pragma unroll
                for (int nt = 0; nt < 4; ++nt) { f32x4 ar = (f32x4){0.f, 0.f, 0.f, 0.f}, ai = ar;
#pragma unroll
                    for (int ks = 0; ks < 2; ++ks) { const bf16x8 wx = *(const LAS bf16x8*)(WXT + (erow + 4 * nt) * 144 + (32 * ks + 8 * fq) * 2);
                        ar = __builtin_amdgcn_mfma_f32_16x16x32_bf16(waf[nt][ks], xcf[ks], ar, 0, 0, 0); ai = __builtin_amdgcn_mfma_f32_16x16x32_bf16(wx, xcf[ks], ai, 0, 0, 0); }
                    const int o = 16 * fq + 4 * nt;
                    const f32x4 ba = *(const LAS f32x4*)(PRM + 8 * 64 + o), bx = *(const LAS f32x4*)(PRM + 9 * 64 + o), nl = *(const LAS f32x4*)(PRM + 10 * 64 + o);
#pragma unroll
                    for (int e = 0; e < 4; ++e) { const int i = 4 * nt + e; const float r = sigm(ar[e] + ba[e]), ig = sigm(ai[e] + bx[e]); const float la = nl[e] * r;
                        const float aa = __expf(la); const float m2 = fmaf(-aa, aa, 1.f);
                        av[i] = aa; bv[i] = __builtin_amdgcn_sqrtf(fmaxf(m2, 0.f)) * ig * xc[i]; }
                    }
            }
            SCAN_STEP(1); SCAN_STEP(2); SCAN_STEP(4); SCAN_STEP(8);
            if (fr == 15) {
#pragma unroll
                for (int i = 0; i < 16; ++i) SEG[wid * 64 + 16 * fq + i] = (f32x2){av[i], bv[i]};
            }
            __syncthreads();
            {   float qs[16]; unpack16(cQS, qs);
                const int drow = 16 * (fr >> 2) + (fr & 3);
#pragma unroll
                for (int nt = 0; nt < 4; ++nt) { f32x4 z = (f32x4){0.f, 0.f, 0.f, 0.f};
#pragma unroll
                    for (int ks = 0; ks < 4; ++ks) { const bf16x8 af = *(const LAS bf16x8*)(VNT + (drow + 4 * nt) * 272 + (32 * ks + 8 * fq) * 2);
                        z = __builtin_amdgcn_mfma_f32_16x16x32_bf16(af, wsf[ks], z, 0, 0, 0); }
#pragma unroll
                    for (int e = 0; e < 4; ++e) outv[4 * nt + e] += qs[4 * nt + e] * (z[e] + bsv);
                    }
            }
            {   const int ch = lane; float h = CARRY[par * 64 + ch];
                for (int w2 = 0; w2 < wid; ++w2) { const f32x2 s = SEG[w2 * 64 + ch]; h = s.x * h + s.y; }
                HIN[wid * 64 + ch] = h;
                if (wid == 7) { const f32x2 s = SEG[7 * 64 + ch]; CARRY[(par ^ 1) * 64 + ch] = s.x * h + s.y; }
            }
            if (more) {
                {   float sm = nS.x + nS.z, sq = nS.y + nS.w; sm += __shfl_xor(sm, 1); sq += __shfl_xor(sq, 1); sm += __shfl_xor(sm, 2); sq += __shfl_xor(sq, 2);
                    const float mean = sm * (1.f / 128.f), var = fmaxf(sq * (1.f / 128.f) - mean * mean, 0.f); if ((tid & 3) == 0) STAT[(par ^ 1) * 128 + (tid >> 2)] = (f32x2){mean, rsqrtf(var + EPS)}; }
                if (fr >= 13 && wid < 7) { LAS unsigned char* hp = lds + MX_PH + (((par ^ 1) * 9 + wid + 1) * 3 + (fr - 13)) * 128 + 32 * fq; LAS unsigned char* hx = hp + (MX_XH - MX_PH);
                    *(LAS u32x4*)hp = nP.a; *(LAS u32x4*)(hp + 16) = nP.b; *(LAS u32x4*)hx = nX.a; *(LAS u32x4*)(hx + 16) = nX.b; }
            }
            __syncthreads();
            {   float qr[16]; unpack16(cQR, qr);
#pragma unroll
                for (int q4 = 0; q4 < 4; ++q4) { const f32x4 hin = *(const LAS f32x4*)(HIN + wid * 64 + 16 * fq + 4 * q4);
#pragma unroll
                    for (int e = 0; e < 4; ++e) { const int i = 4 * q4 + e; outv[i] += qr[i] * (bv[i] + av[i] * hin[e]); } }
            }
            *(u32x4*)(MRG + moff) = (u32x4){cvt_pk_bf16(outv[0], outv[1]), cvt_pk_bf16(outv[2], outv[3]), cvt_pk_bf16(outv[4], outv[5]), cvt_pk_bf16(outv[6], outv[7])};
            *(u32x4*)(MRG + moff + 8) = (u32x4){cvt_pk_bf16(outv[8], outv[9]), cvt_pk_bf16(outv[10], outv[11]), cvt_pk_bf16(outv[12], outv[13]), cvt_pk_bf16(outv[14], outv[15])};
            cP = nP; cX = nX;
#pragma unroll
            for (int i = 0; i < 8; ++i) cV[i] = nV[i];
        }
    }
}

#define XB_TMO      128
#define XB_XCNT(j)  (256  + 64 * (j))
#define XB_XSUB(j)  (1280 + 64 * (j))
#define XB_XGEN(j)  (2304 + 64 * (j))
#define XB_TOP      3328
#define XB_TOPGEN   3392
#define XCD_BAR_WORDS 3456
#define XB_SPIN_CAP (1u << 18)

__device__ __forceinline__ unsigned xb_ld(unsigned* p)              { return __hip_atomic_load(p, __ATOMIC_RELAXED, __HIP_MEMORY_SCOPE_AGENT); }
__device__ __forceinline__ unsigned xb_add(unsigned* p, unsigned v) { return __hip_atomic_fetch_add(p, v, __ATOMIC_RELAXED, __HIP_MEMORY_SCOPE_AGENT); }
__device__ __forceinline__ unsigned xb_xcc_id() { return (unsigned)__builtin_amdgcn_s_getreg((3 << 11) | 20) & 0xFu; }
#define XB_SPIN(cond, bar) do { unsigned _sp = 0; while (cond) { __builtin_amdgcn_s_sleep(1); \
    if ((++_sp & 255u) == 0u) { if (xb_ld(&(bar)[XB_TMO])) break; if (_sp > XB_SPIN_CAP) { atomicAdd(&(bar)[XB_TMO], 1u); break; } } } } while (0)

struct XcdBarrier {
    unsigned* bar; unsigned x;
    volatile LAS unsigned* st;
};

__device__ __forceinline__ XcdBarrier xcd_barrier_post(unsigned* bar, volatile LAS unsigned* st) {
    XcdBarrier b; b.bar = bar; b.x = xb_xcc_id(); b.st = st;
    if (threadIdx.x == 0) (void)xb_add(&bar[XB_XCNT(b.x)], 1u);
    return b;
}
__device__ __forceinline__ void xcd_barrier_complete(unsigned* bar, unsigned x, unsigned& nloc, unsigned& nx) {
    const unsigned G = gridDim.x * gridDim.y * gridDim.z;
    unsigned sum, cnt, mine, sp = 0u;
    for (;;) {
        sum = 0u; cnt = 0u; mine = 0u;
#pragma unroll
        for (unsigned j = 0; j < 16; ++j) { const unsigned c = xb_ld(&bar[XB_XCNT(j)]); sum += c; cnt += (c > 0u) ? 1u : 0u; mine = (j == x) ? c : mine; }
        if (sum == G) break;
        __builtin_amdgcn_s_sleep(1);
        if ((++sp & 255u) == 0u) { if (xb_ld(&bar[XB_TMO])) break; if (sp > XB_SPIN_CAP) { atomicAdd(&bar[XB_TMO], 1u); break; } }
    }
    nloc = mine > 0u ? mine : 1u; nx = cnt > 0u ? cnt : 1u;
}

__device__ __forceinline__ void xcd_barrier(const XcdBarrier& b) {
    asm volatile("s_waitcnt vmcnt(0)" ::: "memory");
    __syncthreads();
    if (threadIdx.x == 0) {
        unsigned bx = b.x; asm volatile("" : "+s"(bx));
        unsigned* bar = b.bar; asm volatile("" : "+s"(bar));
        __builtin_amdgcn_s_waitcnt(0);
        unsigned nloc = b.st[0], nx = b.st[1];
        if (nloc == 0u) { xcd_barrier_complete(bar, bx, nloc, nx); b.st[0] = nloc; b.st[1] = nx; }
        const unsigned old = xb_add(&bar[XB_XSUB(bx)], 1u);
        const unsigned gen = old / nloc;
        if (old + 1u == (gen + 1u) * nloc) {
            __builtin_amdgcn_fence(__ATOMIC_RELEASE, "agent");
            asm volatile("s_waitcnt vmcnt(0)" ::: "memory");
            const unsigned og = xb_add(&bar[XB_TOP], 1u);
            const unsigned tg = og / nx;
            if (og + 1u == (tg + 1u) * nx) xb_add(&bar[XB_TOPGEN], 1u);
            else XB_SPIN(xb_ld(&bar[XB_TOPGEN]) == tg, bar);
            __builtin_amdgcn_fence(__ATOMIC_ACQUIRE, "agent");
            xb_add(&bar[XB_XGEN(bx)], 1u);
            asm volatile("s_waitcnt vmcnt(0)" ::: "memory");
        } else {
            XB_SPIN(xb_ld(&bar[XB_XGEN(bx)]) == gen, bar);
            __builtin_amdgcn_fence(__ATOMIC_ACQUIRE, "agent");
            asm volatile("s_waitcnt vmcnt(0)" ::: "memory");
        }
    }
    __syncthreads();
}


__global__ void __launch_bounds__(512, 2) __attribute__((target("no-packed-fp32-ops"))) fwd_megakernel(Args a) {
    extern __shared__ __attribute__((aligned(16))) unsigned char lds_raw[];
    LAS unsigned char* lds = (LAS unsigned char*)lds_raw;
    cg::grid_group grid = cg::this_grid();
    if (threadIdx.x == 0) {
        LAS unsigned long long* PT = (LAS unsigned long long*)(lds + PT_OFF);
        PT[0] = (unsigned long long)a.in[0]; PT[1] = (unsigned long long)a.in[1]; PT[2] = (unsigned long long)a.in[2]; PT[3] = (unsigned long long)a.in[3]; PT[4] = (unsigned long long)a.in[4];
        PT[5] = (unsigned long long)a.in[5]; PT[6] = (unsigned long long)a.in[6]; PT[7] = (unsigned long long)a.in[7]; PT[8] = (unsigned long long)a.in[8]; PT[9] = (unsigned long long)a.in[9];
        PT[10] = (unsigned long long)a.in[10]; PT[11] = (unsigned long long)a.in[11]; PT[12] = (unsigned long long)a.in[12]; PT[13] = (unsigned long long)a.in[13]; PT[14] = (unsigned long long)a.in[14];
        PT[15] = (unsigned long long)a.in[15]; PT[16] = (unsigned long long)a.in[16]; PT[17] = (unsigned long long)a.in[17]; PT[18] = (unsigned long long)a.out; PT[19] = (unsigned long long)a.ws;
    }
    if (threadIdx.x == 0) { *(LAS unsigned*)(lds + LDS_BARST) = 0u; *(LAS unsigned*)(lds + LDS_BARST + 4) = 0u; }
    __syncthreads();
    const int G = gridDim.x;
    {   pg8::StaticOrder S1; S1.init(M, NIN, G, (int)blockIdx.x); pm_slots_init(lds, S1); }
    const XcdBarrier bar = xcd_barrier_post((unsigned*)(a.ws + WS_CTL), (volatile LAS unsigned*)(lds + LDS_BARST));

    p0_prologue(lds);
    grid.sync();
    p1_prologue(lds);
    xcd_barrier(bar);
    for (int l = 0; l < DEPTH; ++l) {
        {   unsigned char* ws = getp<unsigned char>(lds, I_WS);
            pg8::Gemm g{(const bf16_t*)(ws + WS_H), (const bf16_t*)(ws + WS_WIN) + (size_t)l * NIN * D, M, NIN, D};
            pg8::StaticOrder S; S.init(M, NIN, G, (int)blockIdx.x);
            rstd_prelude(lds, (const float*)(ws + WS_RSS));
            EpiG1 E{lds, l};
            pg8::gemm_phase<EpiG1, true>(lds, g, S, E); }
        if (blockIdx.x < 256) mixer_fill(lds, l, (int)blockIdx.x);
        xcd_barrier(bar);
        mixer_phase(lds, l);
        xcd_barrier(bar);
        {   unsigned char* ws = getp<unsigned char>(lds, I_WS);
            pg8::Gemm g{(const bf16_t*)(ws + WS_MRG), (const bf16_t*)(ws + WS_WOUT) + (size_t)l * D * D, M, D, D};
            pg8::StaticOrder S; S.init(M, D, G, (int)blockIdx.x);
            EpiG2 E{lds, l};
            pg8::gemm_phase<EpiG2, false>(lds, g, S, E); }
        xcd_barrier(bar);
    }
    final_norm(getp<float>(lds, I_OUT), getp<const float>(lds, I_FG));
}

extern "C" void kernel_launch(void* const* d_in, const int* in_sizes, int n_in, void* d_out, int out_size, void* d_ws, size_t ws_size, hipStream_t stream) {
    static int grid = 0;
    if (grid == 0) {
        if (n_in != 18 || in_sizes[0] != M * D || out_size != M * D || ws_size < WS_END) { fprintf(stderr, "kernel_launch: unexpected shapes (n_in %d, in0 %d, out %d, ws %zu)\n", n_in, n_in > 0 ? in_sizes[0] : -1, out_size, ws_size); grid = -1; return; }
        int dev = 0, cus = 0, per_cu = 0;
        if (hipGetDevice(&dev) != hipSuccess || hipDeviceGetAttribute(&cus, hipDeviceAttributeMultiprocessorCount, dev) != hipSuccess) { fprintf(stderr, "kernel_launch: device query failed\n"); grid = -1; return; }
        if (hipFuncSetAttribute((const void*)fwd_megakernel, hipFuncAttributeMaxDynamicSharedMemorySize, LDS_BYTES) != hipSuccess) { fprintf(stderr, "kernel_launch: hipFuncSetAttribute failed\n"); grid = -1; return; }
        if (hipOccupancyMaxActiveBlocksPerMultiprocessor(&per_cu, (const void*)fwd_megakernel, 512, LDS_BYTES) != hipSuccess || per_cu < 1) { fprintf(stderr, "kernel_launch: occupancy query says %d blocks per CU\n", per_cu); per_cu = 1; }
        (void)hipGetLastError();
        grid = cus * per_cu;
    }
    if (grid < 0) return;
    if (hipMemsetAsync((char*)d_ws + WS_CTL, 0, CTL_BYTES, stream) != hipSuccess) { fprintf(stderr, "kernel_launch: memset of the barrier words failed\n"); return; }
    Args a{};
    for (int i = 0; i < 18; ++i) a.in[i] = (const float*)d_in[i];
    a.out = (float*)d_out; a.ws = (unsigned char*)d_ws;
    void* args[] = {&a};
    const hipError_t e = hipLaunchCooperativeKernel((const void*)fwd_megakernel, dim3(grid), dim3(512), args, LDS_BYTES, stream);
    if (e != hipSuccess) fprintf(stderr, "kernel_launch: cooperative launch failed: %s (grid %d)\n", hipGetErrorString(e), grid);
}
```

```cpp
#include <hip/hip_runtime.h>
#include <hip/hip_cooperative_groups.h>
#include <cstdio>
#include <cstdint>
namespace cg = cooperative_groups;

#define LAS __attribute__((address_space(3)))
typedef unsigned short bf16_t;
typedef short bf16x8 __attribute__((ext_vector_type(8)));
typedef float f32x4 __attribute__((ext_vector_type(4)));
typedef float f32x2 __attribute__((ext_vector_type(2)));
typedef unsigned u32x4 __attribute__((ext_vector_type(4)));
typedef unsigned u32x2 __attribute__((ext_vector_type(2)));

constexpr int D = 1024, NB = 16, SEQ = 2048, M = NB * SEQ, DEPTH = 4, NIN = 12288;
constexpr float EPS = 1e-6f;
constexpr size_t MiB = 1u << 20;
constexpr size_t WS_WIN = 0;
constexpr size_t WS_WOUT = 96 * MiB;
constexpr size_t WS_WSB = 104 * MiB;
constexpr size_t WS_WA = 105 * MiB;
constexpr size_t WS_WX = 105 * MiB + 512 * 1024;
constexpr size_t WS_MOD = 106 * MiB;
constexpr size_t WS_H = 112 * MiB;
constexpr size_t WS_MRG = 176 * MiB;
constexpr size_t WS_P = 240 * MiB, WS_QA = 304 * MiB, WS_V = 368 * MiB, WS_QS = 432 * MiB, WS_XR = 496 * MiB, WS_QR = 560 * MiB, WS_SGA = 624 * MiB;
constexpr size_t WS_VST = 688 * MiB;
constexpr size_t WS_RSS = 704 * MiB;
constexpr size_t WS_BIAS = 107 * MiB;
constexpr size_t WS_GP = 110 * MiB;
constexpr size_t WS_CTL = 706 * MiB, CTL_BYTES = 16384;
constexpr size_t WS_END = 707 * MiB;
constexpr int LDS_BYTES = 147456;
constexpr int LDS_RSTD = 133120, LDS_PMS = 141312, LDS_BIAS = 141440, LDS_BARST = 142464, LDS_PMLIST = 142480;

typedef __bf16 bf16x2_t __attribute__((ext_vector_type(2)));
__device__ __forceinline__ unsigned cvt_pk_bf16(float lo, float hi) { const bf16x2_t r = __builtin_convertvector((f32x2){lo, hi}, bf16x2_t); return __builtin_bit_cast(unsigned, r); }
__device__ __forceinline__ float bflo(unsigned u) { return __uint_as_float(u << 16); }
__device__ __forceinline__ float bfhi(unsigned u) { return __uint_as_float(u & 0xffff0000u); }
__device__ __forceinline__ float sigm(float z) { return __builtin_amdgcn_rcpf(1.f + __expf(-z)); }
__device__ __forceinline__ float rows_sum(float v) {
    float a = v, b = v; asm volatile("s_nop 1\n v_permlane16_swap_b32 %0, %1" : "+v"(a), "+v"(b)); const float s = a + b;
    float c = s, d = s; asm volatile("s_nop 1\n v_permlane32_swap_b32 %0, %1" : "+v"(c), "+v"(d)); return c + d;
}
__device__ __forceinline__ float wave_sum(float v) {
#pragma unroll
    for (int o = 1; o < 64; o <<= 1) v += __shfl_xor(v, o);
    return v;
}

struct Args { const float* in[18]; float* out; unsigned char* ws; };
enum { I_X = 0, I_C, I_GAIN, I_WMOD, I_BMOD, I_WIN, I_WOUT, I_CAW, I_SW, I_SB, I_LCW, I_LCB, I_WA, I_BA, I_WX, I_BX, I_LAM, I_FG, I_OUT, I_WS };
constexpr int PT_OFF = 131072 + 1024;
template <class T> __device__ __forceinline__ T* getp(LAS unsigned char* lds, int i) {
    int off = PT_OFF + 8 * i; asm volatile("" : "+v"(off));
    const u32x2 v = *(volatile LAS u32x2*)(lds + off);
    const unsigned lo = __builtin_amdgcn_readfirstlane(v.x), hi = __builtin_amdgcn_readfirstlane(v.y);
    return (T*)(__attribute__((address_space(1))) T*)(((unsigned long long)hi << 32) | (unsigned long long)lo);
}
__device__ __forceinline__ int launder(int v) { asm volatile("" : "+v"(v)); return v; }

namespace pg8 {
constexpr int BM = 256, BK = 64, HALF = 128, HTB = HALF * BK * 2, STAGE_BYTES = 8 * HTB, NXCD = 8, WGM = 8;
__host__ __device__ __forceinline__ int lds_byte(int r, int c) { const int st = (r >> 4) * 2 + (c >> 5), rr = r & 15, cc = c & 31, ob = rr * 64 + cc * 2; return st * 1024 + (ob ^ (((ob >> 9) & 1) << 5)); }
__host__ __device__ __forceinline__ void stage_rc(int b, int& R, int& C) { const int st = b / 1024, sb = b % 1024, swz = sb ^ (((sb >> 9) & 1) << 5); R = (st >> 1) * 16 + swz / 64; C = (st & 1) * 32 + (swz % 64) / 2; }

struct Unit { int pm, pn; };
struct Gemm { const bf16_t* A; const bf16_t* Bt; int M, N, K; };

struct StaticOrder {
    int nM, nN, nwg, G, c;
    __host__ __device__ __forceinline__ void init(int M_, int N_, int G_, int c_) { nM = M_ / BM; nN = N_ / BM; nwg = nM * nN; G = G_; c = c_; }
    __host__ __device__ __forceinline__ bool next(int i, Unit& u) const {
        const long L = (long)i * G + c; if (L >= nwg) return false;
        int wgid = (int)L; { const int q = nwg / NXCD, r = nwg % NXCD, xcd = wgid % NXCD, off = wgid / NXCD; wgid = (xcd < r ? xcd * (q + 1) : r * (q + 1) + (xcd - r) * q) + off; }
        const int nig = WGM * nN, gid = wgid / nig, fm = gid * WGM, gsz = (nM - fm) < WGM ? (nM - fm) : WGM;
        u.pm = fm + ((wgid % nig) % gsz); u.pn = (wgid % nig) / gsz; return true;
    }
};

template <class Epi, bool SEG, bool ALIGN_EPI = true, bool SP2 = true>
__device__ __forceinline__ void gemm_phase(LAS unsigned char* lds, const Gemm g, const StaticOrder& S, const Epi& E) {
    const int tid = launder(threadIdx.x), wid = __builtin_amdgcn_readfirstlane(tid >> 6), lane = tid & 63, wr = wid >> 2, wc = wid & 3, fr = lane & 15, fq = lane >> 4;
    const int K = g.K, nt = K / BK;
    unsigned voffA[2], voffB[2];
#pragma unroll
    for (int i = 0; i < 2; ++i) { int R, C; stage_rc(tid * 16 + i * 8192, R, C);
        const int Rb = SEG ? (((R >> 4) & 1) * 1024 + 16 * (R >> 5) + (R & 15)) : ((R & ~31) + 8 * ((R & 15) >> 2) + 4 * ((R >> 4) & 1) + (R & 3));
        voffA[i] = (unsigned)(R * K + C) * 2u; voffB[i] = (unsigned)(Rb * K + C) * 2u; }
    const size_t kstep = (size_t)(BK * 2);
    const size_t hstep = (size_t)HALF * K * 2;
    const size_t tstep = 2 * hstep;
    const size_t hstepB = SEG ? (size_t)2048 * K * 2 : hstep;
    const unsigned ldsw = (unsigned)wid * 1024u;
    const int aoff = lds_byte(wr * 64 + fr, fq * 8), boff = lds_byte(wc * 32 + fr, fq * 8);
#define PG8_BBASE(pn) (SEG ? ((size_t)(((pn) >> 4) * 4096 + ((pn) & 15) * 64) * K * 2) : ((size_t)(pn) * tstep))
#define PG8_SA(b, h) (((b) * 2 + (h)) * HTB)
#define PG8_SB(b, h) ((4 + (b) * 2 + (h)) * HTB)
#define PG8_STAGE(bufoff, gbase, voff) do { _Pragma("unroll") for (int _i = 0; _i < 2; ++_i) \
        __builtin_amdgcn_global_load_lds((const unsigned*)((const char*)(gbase) + (voff)[_i]), (LAS unsigned*)(lds + (bufoff) + ldsw + _i * 8192), 16, 0, 0); } while (0)
#define PG8_LDA(dst, b, h) do { _Pragma("unroll") for (int m = 0; m < 4; ++m) _Pragma("unroll") for (int k = 0; k < 2; ++k) dst[m][k] = *(const LAS bf16x8*)(lds + PG8_SA(b, h) + aoff + m * 2048 + k * 1024); } while (0)
#define PG8_LDB(dst, b, h) do { _Pragma("unroll") for (int n = 0; n < 2; ++n) _Pragma("unroll") for (int k = 0; k < 2; ++k) dst[n][k] = *(const LAS bf16x8*)(lds + PG8_SB(b, h) + boff + n * 2048 + k * 1024); } while (0)
#define PG8_MMA(ai, bj, At, Bt) do { __builtin_amdgcn_s_setprio(1); _Pragma("unroll") for (int m = 0; m < 4; ++m) _Pragma("unroll") for (int n = 0; n < 2; ++n) _Pragma("unroll") for (int k = 0; k < 2; ++k) \
        acc[ai][bj][m][n] = __builtin_amdgcn_mfma_f32_16x16x32_bf16(Bt[n][k], At[m][k], acc[ai][bj][m][n], 0, 0, 0); __builtin_amdgcn_s_setprio(0); } while (0)
#define PG8_WAIT_V(n) asm volatile("s_waitcnt vmcnt(" #n ")" ::: "memory")
#define PG8_WAIT_L(n) asm volatile("s_waitcnt lgkmcnt(" #n ")" ::: "memory")
#define PG8_BAR __builtin_amdgcn_s_barrier()
#define PG8_SCHED __builtin_amdgcn_sched_barrier(0)
    Unit cur, nxt; int ui = 0;
    if (!S.next(0, cur)) return;
    f32x4 acc[2][2][4][2];
#pragma unroll
    for (int a = 0; a < 2; ++a)
#pragma unroll
        for (int b = 0; b < 2; ++b)
#pragma unroll
            for (int m = 0; m < 4; ++m)
#pragma unroll
                for (int n = 0; n < 2; ++n) acc[a][b][m][n] = (f32x4){0.f, 0.f, 0.f, 0.f};
    bf16x8 At[4][2], B0[2][2], B1[2][2];
    const char* cA = (const char*)g.A + (size_t)cur.pm * tstep; const char* cB = (const char*)g.Bt + PG8_BBASE(cur.pn);
    if constexpr (SP2) {
        PG8_STAGE(PG8_SB(0, 0), cB, voffB); PG8_STAGE(PG8_SB(0, 1), cB + hstepB, voffB); PG8_STAGE(PG8_SA(0, 0), cA, voffA); PG8_STAGE(PG8_SA(0, 1), cA + hstep, voffA);
        if (wr == 1) PG8_BAR;
        PG8_WAIT_V(2); PG8_BAR;
        PG8_STAGE(PG8_SB(1, 0), cB + kstep, voffB); PG8_STAGE(PG8_SA(1, 0), cA + kstep, voffA); PG8_STAGE(PG8_SB(1, 1), cB + hstepB + kstep, voffB);
        PG8_WAIT_V(6); PG8_BAR;
    } else {
        PG8_STAGE(PG8_SB(0, 0), cB, voffB); PG8_STAGE(PG8_SA(0, 0), cA, voffA); PG8_STAGE(PG8_SB(0, 1), cB + hstepB, voffB); PG8_STAGE(PG8_SA(0, 1), cA + hstep, voffA);
        if (wr == 1) PG8_BAR;
        PG8_WAIT_V(4); PG8_BAR;
        PG8_STAGE(PG8_SB(1, 0), cB + kstep, voffB); PG8_STAGE(PG8_SA(1, 0), cA + kstep, voffA); PG8_STAGE(PG8_SB(1, 1), cB + hstepB + kstep, voffB);
        PG8_WAIT_V(6); PG8_BAR;
    }
    for (;;) {
        const bool has_next = S.next(ui + 1, nxt);
        const char* nA = has_next ? (const char*)g.A + (size_t)nxt.pm * tstep : cA; const char* nB = has_next ? (const char*)g.Bt + PG8_BBASE(nxt.pn) : cB;
        static_assert(SP2, "this build keeps only the two-super-phase K-loop");
#define PG8_KBODY(t, last) do { \
            const char* a1 = cA + (size_t)((t) + 1) * kstep; \
            const char* a2 = (last) ? nA : cA + (size_t)((t) + 2) * kstep; const char* b2 = (last) ? nB : cB + (size_t)((t) + 2) * kstep; \
            const char* a3 = a2 + kstep; const char* b3 = b2 + kstep; \
            PG8_LDB(B0, 0, 0); PG8_LDB(B1, 0, 1); PG8_SCHED; PG8_LDA(At, 0, 0); PG8_STAGE(PG8_SA(1, 1), a1 + hstep, voffA); \
            PG8_WAIT_V(8); PG8_WAIT_L(0); PG8_BAR; PG8_MMA(0, 0, At, B0); PG8_MMA(0, 1, At, B1); PG8_BAR; PG8_SCHED; \
            PG8_LDA(At, 0, 1); PG8_STAGE(PG8_SB(0, 0), b2, voffB); PG8_STAGE(PG8_SB(0, 1), b2 + hstepB, voffB); PG8_STAGE(PG8_SA(0, 0), a2, voffA); \
            PG8_WAIT_V(8); PG8_WAIT_L(0); PG8_BAR; PG8_MMA(1, 0, At, B0); PG8_MMA(1, 1, At, B1); PG8_BAR; PG8_SCHED; \
            PG8_LDB(B0, 1, 0); PG8_LDB(B1, 1, 1); PG8_SCHED; PG8_LDA(At, 1, 0); PG8_STAGE(PG8_SA(0, 1), a2 + hstep, voffA); \
            PG8_WAIT_V(8); PG8_WAIT_L(0); PG8_BAR; PG8_MMA(0, 0, At, B0); PG8_MMA(0, 1, At, B1); PG8_BAR; PG8_SCHED; \
            PG8_LDA(At, 1, 1); PG8_STAGE(PG8_SB(1, 0), b3, voffB); PG8_STAGE(PG8_SB(1, 1), b3 + hstepB, voffB); PG8_STAGE(PG8_SA(1, 0), a3, voffA); \
            PG8_WAIT_V(8); PG8_WAIT_L(0); PG8_BAR; PG8_MMA(1, 0, At, B0); PG8_MMA(1, 1, At, B1); PG8_BAR; PG8_SCHED; } while (0)
        for (int t = 0; t < nt; t += 2) { const bool last = (t == nt - 2);
            if (last) E.prefetch(cur, wid, lane);
            PG8_KBODY(t, last); }
#undef PG8_KBODY
        if constexpr (ALIGN_EPI) { if (wr == 0) PG8_BAR; }
        E(acc, cur, wr, wc, fr, fq);
        if (!has_next) break;
#pragma unroll
        for (int a = 0; a < 2; ++a)
#pragma unroll
            for (int b = 0; b < 2; ++b)
#pragma unroll
                for (int m = 0; m < 4; ++m)
#pragma unroll
                    for (int n = 0; n < 2; ++n) acc[a][b][m][n] = (f32x4){0.f, 0.f, 0.f, 0.f};
        cur = nxt; cA = nA; cB = nB; ++ui;
        if constexpr (ALIGN_EPI) { if (wr == 1) PG8_BAR; }
    }
    PG8_WAIT_V(0);
    if constexpr (!ALIGN_EPI) { if (wr == 0) PG8_BAR; }
    PG8_BAR;
#undef PG8_BBASE
#undef PG8_SA
#undef PG8_SB
#undef PG8_STAGE
#undef PG8_LDA
#undef PG8_LDB
#undef PG8_MMA
#undef PG8_WAIT_V
#undef PG8_WAIT_L
#undef PG8_BAR
#undef PG8_SCHED
}
}

struct EpiG1 {
    LAS unsigned char* lds; int l;
    __device__ __forceinline__ void prefetch(const pg8::Unit& u, int wid, int lane) const {
        if (wid == 0) { const float* bias = (const float*)(getp<unsigned char>(lds, I_WS) + WS_BIAS) + (size_t)l * 16 * NIN; lane = launder(lane);
            const float* src = bias + (size_t)(u.pm >> 3) * NIN + (u.pn >> 4) * 4096 + (u.pn & 15) * 64 + (lane >> 4) * 1024 + (lane & 15) * 4;
            __builtin_amdgcn_global_load_lds((const unsigned*)src, (LAS unsigned*)(lds + LDS_BIAS), 16, 0, 0); }
    }
    static __device__ __forceinline__ void rowswap(unsigned& x, unsigned& y) { asm volatile("s_nop 1\n v_permlane16_swap_b32 %0, %1" : "+v"(x), "+v"(y)); }
    template <int TT> __device__ __forceinline__ void body(const f32x4 (&acc)[2][2][4][2], const pg8::Unit& u, int wr, int wc, int fr_, int fq_) const {
        const int fr = launder(fr_), fq = launder(fq_);
        unsigned char* ws = getp<unsigned char>(lds, I_WS);
        const int cb = u.pn & 15;
        const int slot = __builtin_amdgcn_readfirstlane((int)*(const LAS unsigned char*)(lds + LDS_PMS + u.pm));
        const LAS float* rs = (const LAS float*)(lds + LDS_RSTD) + slot * 256 + wr * 64 + fr;
        const LAS float* bl = (const LAS float*)(lds + LDS_BIAS) + wc * 16 + fq * 4;
        const int par = fq & 1, hq = fq >> 1;
        bf16_t* Asel = (bf16_t*)(ws + (TT == 0 ? WS_P : TT == 1 ? WS_V : WS_XR) + (size_t)par * (64 * MiB));
        bf16_t* SGA = (bf16_t*)(ws + WS_SGA); float* VST = (float*)(ws + WS_VST);
        const f32x4 bs0 = *(const LAS f32x4*)bl, bs1 = *(const LAS f32x4*)(bl + 64), bs2 = *(const LAS f32x4*)(bl + 128), bs3 = *(const LAS f32x4*)(bl + 192);
        const int chblk = cb * 4 + wc;
#pragma unroll
        for (int ai = 0; ai < 2; ++ai) {
            const int rb0 = u.pm * 16 + ai * 8 + wr * 4;
            u32x2 sgprev = (u32x2){0u, 0u}; float smprev = 0.f, sqprev = 0.f;
#pragma unroll
            for (int m = 0; m < 4; ++m) {
                const float rstd = rs[ai * 128 + m * 16];
                const f32x4 s0 = acc[ai][0][m][0] * rstd + bs0, s1 = acc[ai][0][m][1] * rstd + bs1, s2 = acc[ai][1][m][0] * rstd + bs2, s3 = acc[ai][1][m][1] * rstd + bs3;
                u32x2 a0, a1;
                if constexpr (TT == 0) {
                    f32x4 p, q;
#pragma unroll
                    for (int e = 0; e < 4; ++e) { p[e] = s2[e] * s0[e]; q[e] = s3[e] * sigm(s3[e]) * s1[e]; }
                    a0 = (u32x2){cvt_pk_bf16(p[0], p[1]), cvt_pk_bf16(p[2], p[3])}; a1 = (u32x2){cvt_pk_bf16(q[0], q[1]), cvt_pk_bf16(q[2], q[3])};
                } else if constexpr (TT == 1) {
                    f32x4 q;
#pragma unroll
                    for (int e = 0; e < 4; ++e) q[e] = (s2[e] * s0[e]) * __builtin_amdgcn_rcpf((1.f + __expf(-s2[e])) * (1.f + __expf(-s3[e])));
                    a0 = (u32x2){cvt_pk_bf16(s1[0], s1[1]), cvt_pk_bf16(s1[2], s1[3])}; a1 = (u32x2){cvt_pk_bf16(q[0], q[1]), cvt_pk_bf16(q[2], q[3])};
                    const float smm = rows_sum((s1[0] + s1[1]) + (s1[2] + s1[3])), sqm = rows_sum((s1[0] * s1[0] + s1[1] * s1[1]) + (s1[2] * s1[2] + s1[3] * s1[3]));
                    if ((m & 1) == 0) { smprev = smm; sqprev = sqm; }
                    else if (hq == 0) {
                        *(f32x2*)(VST + ((((size_t)(rb0 + m - 1 + par) * 8 + (cb >> 1)) * 8 + (cb & 1) * 4 + wc) * 16 + fr) * 2) = par ? (f32x2){smm, sqm} : (f32x2){smprev, sqprev}; }
                } else {
                    f32x4 q, g;
#pragma unroll
                    for (int e = 0; e < 4; ++e) { q[e] = s1[e] * __builtin_amdgcn_rcpf((1.f + __expf(-s1[e])) * (1.f + __expf(-s2[e]))); g[e] = sigm(s3[e]); }
                    a0 = (u32x2){cvt_pk_bf16(s0[0], s0[1]), cvt_pk_bf16(s0[2], s0[3])}; a1 = (u32x2){cvt_pk_bf16(q[0], q[1]), cvt_pk_bf16(q[2], q[3])};
                    const u32x2 sgm = (u32x2){cvt_pk_bf16(g[0], g[1]), cvt_pk_bf16(g[2], g[3])};
                    if ((m & 1) == 0) sgprev = sgm;
                    else {
                        unsigned xx = sgprev.x, xy = sgprev.y, yx = sgm.x, yy = sgm.y; rowswap(xx, yx); rowswap(xy, yy);
                        const size_t so = ((size_t)((rb0 + m - 1 + par) * 64 + chblk)) * 256 + fr * 16 + 8 * hq;
                        __builtin_nontemporal_store((u32x4){xx, xy, yx, yy}, (u32x4*)(SGA + so)); }
                }
                unsigned a0x = a0.x, a0y = a0.y, a1x = a1.x, a1y = a1.y;
                rowswap(a0x, a1x); rowswap(a0y, a1y);
                const size_t off = ((size_t)((rb0 + m) * 64 + chblk)) * 256 + fr * 16 + 8 * hq;
                __builtin_nontemporal_store((u32x4){a0x, a0y, a1x, a1y}, (u32x4*)(Asel + off));
            }
        }
    }
    __device__ __forceinline__ void operator()(const f32x4 (&acc)[2][2][4][2], const pg8::Unit& u, int wr, int wc, int fr, int fq) const {
        const int tt = u.pn >> 4;
        if (tt == 0) body<0>(acc, u, wr, wc, fr, fq); else if (tt == 1) body<1>(acc, u, wr, wc, fr, fq); else body<2>(acc, u, wr, wc, fr, fq);
    }
};
struct EpiG2 {
    LAS unsigned char* lds; int l;
    __device__ __forceinline__ void prefetch(const pg8::Unit&, int, int) const {}
    __device__ __forceinline__ void operator()(const f32x4 (&acc)[2][2][4][2], const pg8::Unit& u, int wr, int wc, int fr_, int fq_) const {
        const int fr = launder(fr_), fq = launder(fq_);
        unsigned char* ws = getp<unsigned char>(lds, I_WS); float* xout = getp<float>(lds, I_OUT);
        const float* xin = (l == 0) ? getp<const float>(lds, I_X) : (const float*)xout;
        const float* gate = (const float*)(ws + WS_MOD) + (size_t)l * 16 * 3072 + 2048;
        const int do_next = l < DEPTH - 1 ? 1 : 0;
        const float* gp = (const float*)(ws + WS_GP) + (size_t)(do_next ? l + 1 : l) * 16 * D; bf16_t* H = (bf16_t*)(ws + WS_H); float* RSS = (float*)(ws + WS_RSS);
        const int b = u.pm >> 3, col0 = u.pn * 256 + wc * 32 + 8 * fq;
        f32x4 gv[2][2], pv[2][2];
#pragma unroll
        for (int bj = 0; bj < 2; ++bj)
#pragma unroll
            for (int n = 0; n < 2; ++n) { gv[bj][n] = *(const f32x4*)(gate + (size_t)b * 3072 + col0 + bj * 128 + n * 4);
                pv[bj][n] = *(const f32x4*)(gp + (size_t)b * D + col0 + bj * 128 + n * 4); }
#pragma unroll
        for (int ai = 0; ai < 2; ++ai)
#pragma unroll
            for (int m = 0; m < 4; ++m) {
                const int row = u.pm * 256 + ai * 128 + wr * 64 + m * 16 + fr;
                const size_t off = (size_t)row * D + col0;
                float ss = 0.f;
#pragma unroll
                for (int bj = 0; bj < 2; ++bj) {
                    const f32x4 x0 = *(const f32x4*)(xin + off + bj * 128), x1 = *(const f32x4*)(xin + off + bj * 128 + 4);
                    const f32x4 o0 = x0 + gv[bj][0] * acc[ai][bj][m][0], o1 = x1 + gv[bj][1] * acc[ai][bj][m][1];
                    *(f32x4*)(xout + off + bj * 128) = o0; *(f32x4*)(xout + off + bj * 128 + 4) = o1;
                    if (do_next) { ss += ((o0.x * o0.x + o0.y * o0.y) + (o0.z * o0.z + o0.w * o0.w)) + ((o1.x * o1.x + o1.y * o1.y) + (o1.z * o1.z + o1.w * o1.w));
                        const f32x4 h0 = o0 * pv[bj][0], h1 = o1 * pv[bj][1];
                        *(u32x4*)(H + off + bj * 128) = (u32x4){cvt_pk_bf16(h0.x, h0.y), cvt_pk_bf16(h0.z, h0.w), cvt_pk_bf16(h1.x, h1.y), cvt_pk_bf16(h1.z, h1.w)}; }
                }
                if (do_next) { ss = rows_sum(ss); if (fq == 0) RSS[(size_t)row * 16 + u.pn * 4 + wc] = ss; }
            }
    }
};

__device__ __forceinline__ void pm_slots_init(LAS unsigned char* lds, const pg8::StaticOrder& S) {
    const int tid = launder(threadIdx.x);
    LAS unsigned char* PMS = lds + LDS_PMS; LAS unsigned char* LIST = lds + LDS_PMLIST;
    if (tid < 128) PMS[tid] = (unsigned char)0xFF;
    __syncthreads();
    if (tid == 0) { int ns = 0; pg8::Unit u; for (int i = 0; S.next(i, u); ++i) if (PMS[u.pm] == 0xFF && ns < 8) { PMS[u.pm] = (unsigned char)ns; LIST[ns] = (unsigned char)u.pm; ++ns; } LIST[8] = (unsigned char)ns; }
    __syncthreads();
}
__device__ __forceinline__ void rstd_prelude(LAS unsigned char* lds, const float* RSS) {
    const int tid = launder(threadIdx.x);
    LAS unsigned char* LIST = lds + LDS_PMLIST; LAS float* RSTD = (LAS float*)(lds + LDS_RSTD);
    const int nslots = __builtin_amdgcn_readfirstlane((int)LIST[8]);
    for (int slot = 0; slot < nslots; ++slot) {
        const int pm = __builtin_amdgcn_readfirstlane((int)LIST[slot]);
        {   const int r = tid >> 1, hf = tid & 1; const f32x4* p = (const f32x4*)(RSS + (size_t)(pm * 256 + r) * 16 + hf * 8); const f32x4 a = p[0], c = p[1];
            float ss = ((a.x + a.y) + (a.z + a.w)) + ((c.x + c.y) + (c.z + c.w)); ss += __shfl_xor(ss, 1);
            if (hf == 0) RSTD[slot * 256 + r] = rsqrtf(ss * (1.f / D) + EPS); }
    }
    __syncthreads();
}

__device__ __forceinline__ void p0_transpose_item(const float* W, int K, int N, bf16_t* WT, int kb, int n0, int drow0, LAS float* scr, int lane) {
    const int k0 = 64 * kb;
    float tv[32];
#pragma unroll
    for (int i = 0; i < 32; ++i) tv[i] = W[(size_t)(k0 + 2 * i + (lane >> 5)) * N + n0 + (lane & 31)];
#pragma unroll
    for (int i = 0; i < 32; ++i) scr[(2 * i + (lane >> 5)) * 33 + (lane & 31)] = tv[i];
    asm volatile("s_waitcnt lgkmcnt(0)" ::: "memory");
    const int c = lane & 7;
#pragma unroll
    for (int j = 0; j < 4; ++j) { const int n = (lane >> 3) + 8 * j; const LAS float* s = scr + (8 * c) * 33 + n;
        u32x4 o; o.x = cvt_pk_bf16(s[0 * 33], s[1 * 33]); o.y = cvt_pk_bf16(s[2 * 33], s[3 * 33]); o.z = cvt_pk_bf16(s[4 * 33], s[5 * 33]); o.w = cvt_pk_bf16(s[6 * 33], s[7 * 33]);
        *(u32x4*)(WT + (size_t)(drow0 + n) * K + k0 + 8 * c) = o; }
    asm volatile("s_waitcnt lgkmcnt(0)" ::: "memory");
}

__device__ __forceinline__ void p0_prologue(LAS unsigned char* lds) {
    const int tid = launder(threadIdx.x), wid = tid >> 6, lane = tid & 63, G = gridDim.x;
    unsigned char* ws = getp<unsigned char>(lds, I_WS);
    const float* in_c = getp<const float>(lds, I_C); const float* in_wmod = getp<const float>(lds, I_WMOD); const float* in_bmod = getp<const float>(lds, I_BMOD);
    {
        LAS float* CA = (LAS float*)lds; LAS float* RED = (LAS float*)(lds + 65536);
        float* MOD = (float*)(ws + WS_MOD);
        for (int u = blockIdx.x; u < 192; u += G) {
            __syncthreads();
            for (int i = tid; i < NB * D; i += 512) { const float v = in_c[i]; CA[i] = v * sigm(v); }
            __syncthreads();
            const int l = u / 48, j0 = (u % 48) * 64;
            const float* wp = in_wmod + (size_t)l * D * 3072 + j0 + lane;
            float acc[16];
#pragma unroll
            for (int b = 0; b < 16; ++b) acc[b] = 0.f;
            for (int k = 128 * wid; k < 128 * wid + 128; k += 16) {
                float wv[16];
#pragma unroll
                for (int q = 0; q < 16; ++q) wv[q] = wp[(size_t)(k + q) * 3072];
#pragma unroll
                for (int q = 0; q < 16; q += 4)
#pragma unroll
                    for (int b = 0; b < 16; ++b) { const f32x4 cv = *(const LAS f32x4*)(CA + b * D + k + q); acc[b] += (cv.x * wv[q] + cv.y * wv[q + 1]) + (cv.z * wv[q + 2] + cv.w * wv[q + 3]); }
            }
#pragma unroll
            for (int b = 0; b < 16; ++b) RED[(wid * 16 + b) * 64 + lane] = acc[b];
            __syncthreads();
            for (int o = tid; o < 1024; o += 512) { const int b = o >> 6, ci = o & 63; float s = in_bmod[l * 3072 + j0 + ci];
#pragma unroll
                for (int w = 0; w < 8; ++w) s += RED[(w * 16 + b) * 64 + ci];
                MOD[(size_t)(l * 16 + b) * 3072 + j0 + ci] = s; }
        }
        __syncthreads();
    }
    {
        LAS float* scr = (LAS float*)(lds + wid * 16384);
        const int gw = blockIdx.x * 8 + wid, NGW = G * 8;
        const float* in_win = getp<const float>(lds, I_WIN); const float* in_wout = getp<const float>(lds, I_WOUT);
        constexpr int I_IN = 16 * 384, I_OUT = 16 * 32, I_L = I_IN + I_OUT;
        for (int it = gw; it < DEPTH * I_L; it += NGW) {
            const int l = it / I_L; int r = it % I_L;
            if (r < I_IN) { const int kb = r / 384, nb = r % 384, n0 = nb * 32, sseg = n0 >> 10;
                const int dseg = (int)((0xA7B986543210ULL >> (4 * sseg)) & 15ULL);
                p0_transpose_item(in_win + (size_t)l * D * NIN, D, NIN, (bf16_t*)(ws + WS_WIN) + (size_t)l * NIN * D, kb, n0, dseg * 1024 + (n0 & 1023), scr, lane);
            } else { r -= I_IN; const int kb = r / 32, nb = r % 32;
                p0_transpose_item(in_wout + (size_t)l * D * D, D, D, (bf16_t*)(ws + WS_WOUT) + (size_t)l * D * D, kb, nb * 32, nb * 32, scr, lane); }
        }
    }
    {
        const int gt = blockIdx.x * 512 + tid, NT = G * 512;
        const float* in_sw = getp<const float>(lds, I_SW); const float* in_wa = getp<const float>(lds, I_WA); const float* in_wx = getp<const float>(lds, I_WX);
        bf16_t* WSB = (bf16_t*)(ws + WS_WSB);
        for (int i = gt; i < DEPTH * 8 * 128 * 128 / 2; i += NT) { const int e0 = 2 * i, t = (e0 >> 7) & 127, s = e0 & 127; const f32x2 v = *(const f32x2*)(in_sw + e0);
            *(unsigned*)(WSB + e0) = cvt_pk_bf16(s <= t ? v.x : 0.f, (s + 1) <= t ? v.y : 0.f); }
        bf16_t* WA = (bf16_t*)(ws + WS_WA); bf16_t* WX = (bf16_t*)(ws + WS_WX);
        for (int i = gt; i < DEPTH * 16 * 64 * 64; i += NT) { const int d = i & 63, e = (i >> 6) & 63, lh = i >> 12;
            const float va = in_wa[(size_t)lh * 4096 + d * 64 + e], vx = in_wx[(size_t)lh * 4096 + d * 64 + e];
            WA[i] = (bf16_t)(cvt_pk_bf16(va, 0.f) & 0xffffu); WX[i] = (bf16_t)(cvt_pk_bf16(vx, 0.f) & 0xffffu); }
    }
}

__device__ __forceinline__ void p1_prologue(LAS unsigned char* lds) {
    const int tid = launder(threadIdx.x), wid = tid >> 6, lane = tid & 63, G = gridDim.x;
    unsigned char* ws = getp<unsigned char>(lds, I_WS);
    const float* MOD = (const float*)(ws + WS_MOD);
    {   const int gt = blockIdx.x * 512 + tid, NT = G * 512; const float* gain = getp<const float>(lds, I_GAIN); float* GP = (float*)(ws + WS_GP);
        for (int i = gt; i < DEPTH * NB * D; i += NT) { const int l = i >> 14, b = (i >> 10) & 15, col = i & 1023; GP[i] = gain[l * D + col] * (1.f + MOD[(size_t)(l * 16 + b) * 3072 + 1024 + col]); } }
    {   const float* xin = getp<const float>(lds, I_X); const float* gain = getp<const float>(lds, I_GAIN); bf16_t* H = (bf16_t*)(ws + WS_H); float* RSS = (float*)(ws + WS_RSS);
        const int gw = blockIdx.x * 8 + wid, NGW = G * 8;
        for (int row = gw; row < M; row += NGW) {
            const int b = row >> 11;
            const f32x4* xr = (const f32x4*)(xin + (size_t)row * D) + lane;
            f32x4 v[4]; float ss = 0.f;
#pragma unroll
            for (int j = 0; j < 4; ++j) { v[j] = xr[64 * j]; ss += (v[j].x * v[j].x + v[j].y * v[j].y) + (v[j].z * v[j].z + v[j].w * v[j].w); }
            ss = wave_sum(ss);
            if (lane < 16) RSS[(size_t)row * 16 + lane] = lane == 0 ? ss : 0.f;
#pragma unroll
            for (int j = 0; j < 4; ++j) { const int col = 4 * lane + 256 * j;
                const f32x4 g = *(const f32x4*)(gain + col), sc = *(const f32x4*)(MOD + (size_t)b * 3072 + 1024 + col);
                const f32x4 o = v[j] * g * (sc + 1.f);
                *(u32x2*)(H + (size_t)row * D + col) = (u32x2){cvt_pk_bf16(o.x, o.y), cvt_pk_bf16(o.z, o.w)}; }
        }
    }
    {
        float* BIAS = (float*)(ws + WS_BIAS); const bf16_t* WT = (const bf16_t*)(ws + WS_WIN);
        const int gw = blockIdx.x * 8 + wid, NGW = G * 8, fr = lane & 15, fq = lane >> 4;
        for (int it = gw; it < DEPTH * (NIN / 16); it += NGW) {
            const int l = it / (NIN / 16), n0 = (it % (NIN / 16)) * 16;
            const bf16_t* wrow = WT + ((size_t)l * NIN + n0 + fr) * D + 8 * fq;
            const float* srow = MOD + (size_t)(l * 16 + fr) * 3072 + 8 * fq;
            f32x4 acc = (f32x4){0.f, 0.f, 0.f, 0.f};
#pragma unroll 8
            for (int ks = 0; ks < 32; ++ks) {
                const bf16x8 bfrag = *(const bf16x8*)(wrow + 32 * ks);
                const f32x4 s0 = *(const f32x4*)(srow + 32 * ks), s1 = *(const f32x4*)(srow + 32 * ks + 4);
                const u32x4 ap = (u32x4){cvt_pk_bf16(s0.x, s0.y), cvt_pk_bf16(s0.z, s0.w), cvt_pk_bf16(s1.x, s1.y), cvt_pk_bf16(s1.z, s1.w)};
                acc = __builtin_amdgcn_mfma_f32_16x16x32_bf16(__builtin_bit_cast(bf16x8, ap), bfrag, acc, 0, 0, 0);
            }
#pragma unroll
            for (int e = 0; e < 4; ++e) BIAS[(size_t)(l * 16 + 4 * fq + e) * NIN + n0 + fr] = acc[e];
        }
    }
}

__device__ __forceinline__ void norm_phase(const float* xin, bf16_t* H, const float* gain, const float* modl) {
    const int tid = launder(threadIdx.x), wid = tid >> 6, lane = tid & 63;
    const int gw = blockIdx.x * 8 + wid, NGW = gridDim.x * 8;
    for (int row = gw; row < M; row += NGW) {
        const int b = row >> 11;
        const f32x4* xr = (const f32x4*)(xin + (size_t)row * D) + lane;
        f32x4 v[4]; float ss = 0.f;
#pragma unroll
        for (int j = 0; j < 4; ++j) { v[j] = xr[64 * j]; ss += (v[j].x * v[j].x + v[j].y * v[j].y) + (v[j].z * v[j].z + v[j].w * v[j].w); }
        const float rstd = rsqrtf(wave_sum(ss) * (1.f / D) + EPS);
#pragma unroll
        for (int j = 0; j < 4; ++j) { const int col = 4 * lane + 256 * j;
            const f32x4 g = *(const f32x4*)(gain + col), sh = *(const f32x4*)(modl + (size_t)b * 3072 + col), sc = *(const f32x4*)(modl + (size_t)b * 3072 + 1024 + col);
            const f32x4 o = v[j] * rstd * g * (sc + 1.f) + sh;
            *(u32x2*)(H + (size_t)row * D + col) = (u32x2){cvt_pk_bf16(o.x, o.y), cvt_pk_bf16(o.z, o.w)}; }
    }
}
__device__ __forceinline__ void final_norm(float* x, const float* gain) {
    const int tid = launder(threadIdx.x), wid = tid >> 6, lane = tid & 63;
    const int gw = blockIdx.x * 8 + wid, NGW = gridDim.x * 8;
    for (int row = gw; row < M; row += NGW) {
        f32x4* xr = (f32x4*)(x + (size_t)row * D) + lane;
        f32x4 v[4]; float ss = 0.f;
#pragma unroll
        for (int j = 0; j < 4; ++j) { v[j] = xr[64 * j]; ss += (v[j].x * v[j].x + v[j].y * v[j].y) + (v[j].z * v[j].z + v[j].w * v[j].w); }
        const float rstd = rsqrtf(wave_sum(ss) * (1.f / D) + EPS);
#pragma unroll
        for (int j = 0; j < 4; ++j) { const f32x4 g = *(const f32x4*)(gain + 4 * lane + 256 * j); xr[64 * j] = v[j] * rstd * g; }
    }
}

struct U8 { u32x4 a, b; };
__device__ __forceinline__ U8 ld16(const bf16_t* p, bool ok) { U8 r; if (ok) { r.a = *(const u32x4*)p; r.b = *(const u32x4*)(p + 8); } else { r.a = (u32x4){0u, 0u, 0u, 0u}; r.b = r.a; } return r; }
__device__ __forceinline__ void unpack16(const U8& u, float (&o)[16]) {
    o[0] = bflo(u.a.x); o[1] = bfhi(u.a.x); o[2] = bflo(u.a.y); o[3] = bfhi(u.a.y); o[4] = bflo(u.a.z); o[5] = bfhi(u.a.z); o[6] = bflo(u.a.w); o[7] = bfhi(u.a.w);
    o[8] = bflo(u.b.x); o[9] = bfhi(u.b.x); o[10] = bflo(u.b.y); o[11] = bfhi(u.b.y); o[12] = bflo(u.b.z); o[13] = bfhi(u.b.z); o[14] = bflo(u.b.w); o[15] = bfhi(u.b.w);
}
template <int N> __device__ __forceinline__ float dpp_shr(float v, float ident) {
    return __builtin_bit_cast(float, __builtin_amdgcn_update_dpp(__builtin_bit_cast(int, ident), __builtin_bit_cast(int, v), 0x110 + N, 0xf, 0xf, false));
}
template <int N> __device__ __forceinline__ unsigned dppi(unsigned v, unsigned old) { return (unsigned)__builtin_amdgcn_update_dpp((int)old, (int)v, 0x110 + N, 0xf, 0xf, false); }
template <int N> __device__ __forceinline__ U8 shr_rows(const U8& cur, const U8& halo) { U8 r;
    r.a.x = dppi<N>(cur.a.x, halo.a.x); r.a.y = dppi<N>(cur.a.y, halo.a.y); r.a.z = dppi<N>(cur.a.z, halo.a.z); r.a.w = dppi<N>(cur.a.w, halo.a.w);
    r.b.x = dppi<N>(cur.b.x, halo.b.x); r.b.y = dppi<N>(cur.b.y, halo.b.y); r.b.z = dppi<N>(cur.b.z, halo.b.z); r.b.w = dppi<N>(cur.b.w, halo.b.w); return r; }
template <int N> __device__ __forceinline__ float row_bcast(float v) { return __builtin_bit_cast(float, __builtin_amdgcn_update_dpp(0, __builtin_bit_cast(int, v), 0x150 + N, 0xf, 0xf, true)); }
template <int N> __device__ __forceinline__ float fmac_bc(float acc, float k, float x) { asm("v_fmac_f32_dpp %0, %1, %2 row_newbcast:%3 row_mask:0xf bank_mask:0xf" : "+v"(acc) : "v"(k), "v"(x), "n"(N)); return acc; }
template <int N> __device__ __forceinline__ float mul_bc(float k, float x) { float r; asm("v_mul_f32_dpp %0, %1, %2 row_newbcast:%3 row_mask:0xf bank_mask:0xf" : "=v"(r) : "v"(k), "v"(x), "n"(N)); return r; }
template <int N> __device__ __forceinline__ u32x4 shr4(const u32x4 cur, const u32x4 halo) { u32x4 r; r.x = dppi<N>(cur.x, halo.x); r.y = dppi<N>(cur.y, halo.y); r.z = dppi<N>(cur.z, halo.z); r.w = dppi<N>(cur.w, halo.w); return r; }
__device__ __forceinline__ void unpack8(const u32x4 u, float (&o)[8]) { o[0] = bflo(u.x); o[1] = bfhi(u.x); o[2] = bflo(u.y); o[3] = bfhi(u.y); o[4] = bflo(u.z); o[5] = bfhi(u.z); o[6] = bflo(u.w); o[7] = bfhi(u.w); }
__device__ __forceinline__ U8 lds16(const LAS unsigned char* p) { U8 r; r.a = *(const LAS u32x4*)p; r.b = *(const LAS u32x4*)(p + 16); return r; }
#define SCAN8(N, o) asm volatile("s_nop 1\n" \
    "v_fmac_f32_dpp %8, %8, %0 row_shr:" #N " row_mask:0xf bank_mask:0xf\n v_fmac_f32_dpp %9, %9, %1 row_shr:" #N " row_mask:0xf bank_mask:0xf\n" \
    "v_fmac_f32_dpp %10, %10, %2 row_shr:" #N " row_mask:0xf bank_mask:0xf\n v_fmac_f32_dpp %11, %11, %3 row_shr:" #N " row_mask:0xf bank_mask:0xf\n" \
    "v_fmac_f32_dpp %12, %12, %4 row_shr:" #N " row_mask:0xf bank_mask:0xf\n v_fmac_f32_dpp %13, %13, %5 row_shr:" #N " row_mask:0xf bank_mask:0xf\n" \
    "v_fmac_f32_dpp %14, %14, %6 row_shr:" #N " row_mask:0xf bank_mask:0xf\n v_fmac_f32_dpp %15, %15, %7 row_shr:" #N " row_mask:0xf bank_mask:0xf\n" \
    "v_mul_f32_dpp %0, %0, %0 row_shr:" #N " row_mask:0xf bank_mask:0xf\n v_mul_f32_dpp %1, %1, %1 row_shr:" #N " row_mask:0xf bank_mask:0xf\n" \
    "v_mul_f32_dpp %2, %2, %2 row_shr:" #N " row_mask:0xf bank_mask:0xf\n v_mul_f32_dpp %3, %3, %3 row_shr:" #N " row_mask:0xf bank_mask:0xf\n" \
    "v_mul_f32_dpp %4, %4, %4 row_shr:" #N " row_mask:0xf bank_mask:0xf\n v_mul_f32_dpp %5, %5, %5 row_shr:" #N " row_mask:0xf bank_mask:0xf\n" \
    "v_mul_f32_dpp %6, %6, %6 row_shr:" #N " row_mask:0xf bank_mask:0xf\n v_mul_f32_dpp %7, %7, %7 row_shr:" #N " row_mask:0xf bank_mask:0xf\n" \
    : "+v"(av[o + 0]), "+v"(av[o + 1]), "+v"(av[o + 2]), "+v"(av[o + 3]), "+v"(av[o + 4]), "+v"(av[o + 5]), "+v"(av[o + 6]), "+v"(av[o + 7]), \
      "+v"(bv[o + 0]), "+v"(bv[o + 1]), "+v"(bv[o + 2]), "+v"(bv[o + 3]), "+v"(bv[o + 4]), "+v"(bv[o + 5]), "+v"(bv[o + 6]), "+v"(bv[o + 7]))
#define SCAN_STEP(N) do { SCAN8(N, 0); SCAN8(N, 8); } while (0)

constexpr int MX_VNT = 0, MX_XC = 17408, MX_WAT = 35840, MX_WXT = 45056, MX_PRM = 54272, MX_STAT = 57344, MX_SEG = 59392, MX_HIN = 63488, MX_CARRY = 65536, MX_WS = 66048, MX_PH = 100864, MX_XH = 107776;

__device__ __forceinline__ int mixer_unit_of(int c) { return (c < 256) ? (((2 * (c & 7) + ((c >> 3) >> 4)) << 4) | ((c >> 3) & 15)) : c; }
__device__ __forceinline__ void mixer_fill(LAS unsigned char* lds, int l, int u) {
    const int tid = launder(threadIdx.x);
    unsigned char* ws = getp<unsigned char>(lds, I_WS);
    const int j = u & 15, hh = j >> 1;
    LAS unsigned char* WAT = lds + MX_WAT; LAS unsigned char* WXT = lds + MX_WXT; LAS float* PRM = (LAS float*)(lds + MX_PRM); LAS float* CARRY = (LAS float*)(lds + MX_CARRY);
        {   const int e = tid >> 3, d0 = (tid & 7) * 8;
        const size_t wo = ((size_t)(l * 16 + j) * 64 + e) * 64 + d0;
        *(LAS u32x4*)(WAT + e * 144 + d0 * 2) = *(const u32x4*)((const bf16_t*)(ws + WS_WA) + wo);
        *(LAS u32x4*)(WXT + e * 144 + d0 * 2) = *(const u32x4*)((const bf16_t*)(ws + WS_WX) + wo); }
    for (int i = tid; i < 11 * 64; i += 512) { const int r = i >> 6, ch = 64 * j + (i & 63); float v;
        if (r < 3) v = getp<const float>(lds, I_CAW)[(l * 3 + r) * D + ch];
        else if (r < 7) v = getp<const float>(lds, I_LCW)[(l * 4 + (r - 3)) * D + ch];
        else if (r == 7) v = getp<const float>(lds, I_LCB)[l * D + ch];
        else if (r == 8) v = getp<const float>(lds, I_BA)[l * D + ch];
        else if (r == 9) v = getp<const float>(lds, I_BX)[l * D + ch];
        else v = -8.f * log1pf(expf(-getp<const float>(lds, I_LAM)[l * D + ch]));
        PRM[i] = v; }
    if (tid < 128) CARRY[tid] = 0.f;
    if (tid < 96) { *(LAS unsigned*)(lds + MX_PH + 4 * tid) = 0u; *(LAS unsigned*)(lds + MX_XH + 4 * tid) = 0u; }
#pragma unroll
    for (int i = 0; i < 4; ++i) { const int q = tid + 512 * i, row = q >> 4, c16 = q & 15;
        *(LAS u32x4*)(lds + MX_WS + row * 272 + c16 * 16) = *(const u32x4*)((const bf16_t*)(ws + WS_WSB) + ((size_t)((l * 8 + hh) * 128 + row)) * 128 + c16 * 8); }
}

__device__ __forceinline__ void mixer_phase(LAS unsigned char* lds, int l) {
    const int tid0 = launder(threadIdx.x), wid = __builtin_amdgcn_readfirstlane(tid0 >> 6);
    unsigned char* ws = getp<unsigned char>(lds, I_WS);
    const bf16_t* P = (const bf16_t*)(ws + WS_P); const bf16_t* QA = (const bf16_t*)(ws + WS_QA); const bf16_t* V = (const bf16_t*)(ws + WS_V); const bf16_t* QS = (const bf16_t*)(ws + WS_QS);
    const bf16_t* XR = (const bf16_t*)(ws + WS_XR); const bf16_t* QR = (const bf16_t*)(ws + WS_QR); const bf16_t* SGA = (const bf16_t*)(ws + WS_SGA);
    const float* VST = (const float*)(ws + WS_VST); bf16_t* MRG = (bf16_t*)(ws + WS_MRG);
    LAS unsigned char* VNT = lds + MX_VNT; LAS unsigned char* XC = lds + MX_XC; LAS unsigned char* WAT = lds + MX_WAT; LAS unsigned char* WXT = lds + MX_WXT;
    LAS float* PRM = (LAS float*)(lds + MX_PRM); LAS f32x2* STAT = (LAS f32x2*)(lds + MX_STAT); LAS f32x2* SEG = (LAS f32x2*)(lds + MX_SEG);
    LAS float* HIN = (LAS float*)(lds + MX_HIN); LAS float* CARRY = (LAS float*)(lds + MX_CARRY);
    for (int u0 = blockIdx.x; u0 < 256; u0 += gridDim.x) {
        int u = mixer_unit_of(u0); asm volatile("" : "+s"(u));
        const int b = u >> 4, j = u & 15, hh = j >> 1;
        const int tid = launder(tid0), lane0 = tid & 63, fr = lane0 & 15;
        __syncthreads();
        if (u0 != (int)blockIdx.x) mixer_fill(lds, l, u);
        const float bsv = getp<const float>(lds, I_SB)[(l * 8 + hh) * 128 + 16 * wid + fr];
        float kR[5], kA[3];
        __syncthreads();
#pragma unroll
        for (int r = 0; r < 5; ++r) kR[r] = PRM[(3 + r) * 64 + lane0];
#pragma unroll
        for (int r = 0; r < 3; ++r) kA[r] = PRM[r * 64 + lane0];
        bf16x8 waf[4][2];
#pragma unroll
        for (int nt = 0; nt < 4; ++nt)
#pragma unroll
            for (int ks = 0; ks < 2; ++ks) waf[nt][ks] = *(const LAS bf16x8*)(WAT + (16 * ((lane0 & 15) >> 2) + (lane0 & 3) + 4 * nt) * 144 + (32 * ks + 8 * (lane0 >> 4)) * 2);
        bf16x8 wsf[4];
#pragma unroll
        for (int ks = 0; ks < 4; ++ks) wsf[ks] = *(const LAS bf16x8*)(lds + MX_WS + (16 * wid + fr) * 272 + (32 * ks + 8 * (lane0 >> 4)) * 2);
        unsigned cV[8], nV[8]; U8 cP, cX, nP, nX; f32x4 nS;
        {   const int lane = launder(lane0), fr = lane & 15, fq = lane >> 4, tid = wid * 64 + lane, R = tid >> 5, C = tid & 31;
            const int r0 = b * SEQ; const unsigned eoff = (unsigned)((((r0 >> 4) + wid) * 64 + 4 * j + fq) * 256 + fr * 16);
#pragma unroll
            for (int i = 0; i < 8; ++i) cV[i] = *(const unsigned*)(V + (unsigned)((((r0 >> 4) + (R >> 1)) * 64 + 4 * j + (C >> 3)) * 256 + (8 * (R & 1) + i) * 16 + 2 * (C & 7)));
            cP = ld16(P + eoff, true); cX = ld16(XR + eoff, true);
            {   const unsigned so = (unsigned)((((((r0 + (tid >> 2)) >> 4) * 8 + hh) * 8 + 2 * (tid & 3)) * 16 + ((tid >> 2) & 15)) * 2);
                const f32x2 sa = *(const f32x2*)(VST + so), sb = *(const f32x2*)(VST + so + 32); const f32x4 sv = (f32x4){sa.x, sa.y, sb.x, sb.y};
                float sm = sv.x + sv.z, sq = sv.y + sv.w; sm += __shfl_xor(sm, 1); sq += __shfl_xor(sq, 1); sm += __shfl_xor(sm, 2); sq += __shfl_xor(sq, 2);
                const float mean = sm * (1.f / 128.f), var = fmaxf(sq * (1.f / 128.f) - mean * mean, 0.f); if ((tid & 3) == 0) STAT[tid >> 2] = (f32x2){mean, rsqrtf(var + EPS)}; }
            if (fr >= 13 && wid < 7) { LAS unsigned char* hp = lds + MX_PH + ((wid + 1) * 3 + (fr - 13)) * 128 + 32 * fq; LAS unsigned char* hx = hp + (MX_XH - MX_PH);
                *(LAS u32x4*)hp = cP.a; *(LAS u32x4*)(hp + 16) = cP.b; *(LAS u32x4*)hx = cX.a; *(LAS u32x4*)(hx + 16) = cX.b; }
        }
        __syncthreads();
        for (int c = 0; c < 16; ++c) {
            const int lane = launder(lane0), fr = lane & 15, fq = lane >> 4, tid = wid * 64 + lane;
            const int r0 = b * SEQ + c * 128, trow = 16 * wid + fr;
            const unsigned moff = (unsigned)((r0 + trow) * D + 64 * j + 16 * fq);
            const unsigned eoff = (unsigned)((((r0 >> 4) + wid) * 64 + 4 * j + fq) * 256 + fr * 16);
            const int R = tid >> 5, C = tid & 31;
            const int par = c & 1; const bool more = c < 15;
            const U8 cQA = ld16(QA + eoff, true), cSG = ld16(SGA + eoff, true);
            if (wid == 7 && fr >= 13) {
                LAS unsigned char* hp = lds + MX_PH + (((par ^ 1) * 9) * 3 + (fr - 13)) * 128 + 32 * fq; LAS unsigned char* hx = hp + (MX_XH - MX_PH);
                *(LAS u32x4*)hp = cP.a; *(LAS u32x4*)(hp + 16) = cP.b; *(LAS u32x4*)hx = cX.a; *(LAS u32x4*)(hx + 16) = cX.b; }
            {   float lo[8], hi[8];
#pragma unroll
                for (int i = 0; i < 8; ++i) { const f32x2 st = STAT[par * 128 + 8 * R + i]; lo[i] = (bflo(cV[i]) - st.x) * st.y; hi[i] = (bfhi(cV[i]) - st.x) * st.y; }
                *(LAS u32x4*)(VNT + (2 * C) * 272 + 16 * R) = (u32x4){cvt_pk_bf16(lo[0], lo[1]), cvt_pk_bf16(lo[2], lo[3]), cvt_pk_bf16(lo[4], lo[5]), cvt_pk_bf16(lo[6], lo[7])};
                *(LAS u32x4*)(VNT + (2 * C + 1) * 272 + 16 * R) = (u32x4){cvt_pk_bf16(hi[0], hi[1]), cvt_pk_bf16(hi[2], hi[3]), cvt_pk_bf16(hi[4], hi[5]), cvt_pk_bf16(hi[6], hi[7])};
            }
            float outv[16], xc[16];
            const LAS unsigned char* hbase = lds + MX_PH + (par * 9 + wid) * 384 + 32 * fq;
#pragma unroll
            for (int hf = 0; hf < 2; ++hf) {
                float x0[8], x1[8], x2[8], x3[8];
                {   const LAS unsigned char* hx = hbase + (MX_XH - MX_PH) + 16 * hf; const u32x4 cx = hf ? cX.b : cX.a;
                    u32x4 h1 = (u32x4){0u, 0u, 0u, 0u}, h2 = h1, h3 = h1;
                    if (fr < 3) { h1 = *(const LAS u32x4*)(hx + 2 * 128); h2 = *(const LAS u32x4*)(hx + min(1 + fr, 2) * 128); h3 = *(const LAS u32x4*)(hx + fr * 128); }
                    unpack8(shr4<1>(cx, h1), x1); unpack8(shr4<2>(cx, h2), x2); unpack8(shr4<3>(cx, h3), x3); unpack8(cx, x0); }
#define CONVR(i) xc[8 * hf + i] = fmac_bc<8 * HF + i>(fmac_bc<8 * HF + i>(fmac_bc<8 * HF + i>(fmac_bc<8 * HF + i>(row_bcast<8 * HF + i>(kR[4]), kR[0], x3[i]), kR[1], x2[i]), kR[2], x1[i]), kR[3], x0[i])
                if (hf == 0) { constexpr int HF = 0; CONVR(0); CONVR(1); CONVR(2); CONVR(3); CONVR(4); CONVR(5); CONVR(6); CONVR(7); }
                else { constexpr int HF = 1; CONVR(0); CONVR(1); CONVR(2); CONVR(3); CONVR(4); CONVR(5); CONVR(6); CONVR(7); }
#undef CONVR
                *(LAS u32x4*)(XC + trow * 144 + 32 * fq + 16 * hf) = (u32x4){cvt_pk_bf16(xc[8 * hf + 0], xc[8 * hf + 1]), cvt_pk_bf16(xc[8 * hf + 2], xc[8 * hf + 3]), cvt_pk_bf16(xc[8 * hf + 4], xc[8 * hf + 5]), cvt_pk_bf16(xc[8 * hf + 6], xc[8 * hf + 7])};
            }
#pragma unroll
            for (int hf = 0; hf < 2; ++hf) {
                float p0[8], p1[8], p2[8], qa[8], sg[8];
                {   const u32x4 cp = hf ? cP.b : cP.a;
                    u32x4 h1 = (u32x4){0u, 0u, 0u, 0u}, h2 = h1;
                    if (fr < 2) { h1 = *(const LAS u32x4*)(hbase + 2 * 128 + 16 * hf); h2 = *(const LAS u32x4*)(hbase + (1 + fr) * 128 + 16 * hf); }
                    unpack8(shr4<1>(cp, h1), p1); unpack8(shr4<2>(cp, h2), p2); unpack8(cp, p0); unpack8(hf ? cQA.b : cQA.a, qa); unpack8(hf ? cSG.b : cSG.a, sg); }
#define CONVA(i) outv[8 * hf + i] = sg[i] * qa[i] * fmac_bc<8 * HF + i>(fmac_bc<8 * HF + i>(mul_bc<8 * HF + i>(kA[0], p2[i]), kA[1], p1[i]), kA[2], p0[i])
                if (hf == 0) { constexpr int HF = 0; CONVA(0); CONVA(1); CONVA(2); CONVA(3); CONVA(4); CONVA(5); CONVA(6); CONVA(7); }
                else { constexpr int HF = 1; CONVA(0); CONVA(1); CONVA(2); CONVA(3); CONVA(4); CONVA(5); CONVA(6); CONVA(7); }
#undef CONVA
            }
            const U8 cQS = ld16(QS + eoff, true), cQR = ld16(QR + eoff, true);
            {
                const int rn = more ? r0 + 128 : r0; const unsigned noff = (unsigned)((((rn >> 4) + wid) * 64 + 4 * j + fq) * 256 + fr * 16);
#pragma unroll
                for (int i = 0; i < 8; ++i) nV[i] = *(const unsigned*)(V + (unsigned)((((rn >> 4) + (R >> 1)) * 64 + 4 * j + (C >> 3)) * 256 + (8 * (R & 1) + i) * 16 + 2 * (C & 7)));
                nP = ld16(P + noff, true); nX = ld16(XR + noff, true);
                {   const unsigned so = (unsigned)((((((rn + (tid >> 2)) >> 4) * 8 + hh) * 8 + 2 * (tid & 3)) * 16 + ((tid >> 2) & 15)) * 2);
                    const f32x2 sa = *(const f32x2*)(VST + so), sb = *(const f32x2*)(VST + so + 32); nS = (f32x4){sa.x, sa.y, sb.x, sb.y}; }
            }
            float av[16], bv[16];
            {   bf16x8 xcf[2];
#pragma unroll
                for (int ks = 0; ks < 2; ++ks) xcf[ks] = *(const LAS bf16x8*)(XC + trow * 144 + (32 * ks + 8 * fq) * 2);
                const int erow = 16 * (fr >> 2) + (fr & 3);
#pragma unroll
                for (int nt = 0; nt < 4; ++nt) { f32x4 ar = (f32x4){0.f, 0.f, 0.f, 0.f}, ai = ar;
#pragma unroll
                    for (int ks = 0; ks < 2; ++ks) { const bf16x8 wx = *(const LAS bf16x8*)(WXT + (erow + 4 * nt) * 144 + (32 * ks + 8 * fq) * 2);
                        ar = __builtin_amdgcn_mfma_f32_16x16x32_bf16(waf[nt][ks], xcf[ks], ar, 0, 0, 0); ai = __builtin_amdgcn_mfma_f32_16x16x32_bf16(wx, xcf[ks], ai, 0, 0, 0); }
                    const int o = 16 * fq + 4 * nt;
                    const f32x4 ba = *(const LAS f32x4*)(PRM + 8 * 64 + o), bx = *(const LAS f32x4*)(PRM + 9 * 64 + o), nl = *(const LAS f32x4*)(PRM + 10 * 64 + o);
#pragma unroll
                    for (int e = 0; e < 4; ++e) { const int i = 4 * nt + e; const float r = sigm(ar[e] + ba[e]), ig = sigm(ai[e] + bx[e]); const float la = nl[e] * r;
                        const float aa = __expf(la); const float m2 = fmaf(-aa, aa, 1.f);
                        av[i] = aa; bv[i] = __builtin_amdgcn_sqrtf(fmaxf(m2, 0.f)) * ig * xc[i]; }
                    }
            }
            SCAN_STEP(1); SCAN_STEP(2); SCAN_STEP(4); SCAN_STEP(8);
            if (fr == 15) {
#pragma unroll
                for (int i = 0; i < 16; ++i) SEG[wid * 64 + 16 * fq + i] = (f32x2){av[i], bv[i]};
            }
            __syncthreads();
            {   float qs[16]; unpack16(cQS, qs);
                const int drow = 16 * (fr >> 2) + (fr & 3);
#pragma unroll
                for (int nt = 0; nt < 4; ++nt) { f32x4 z = (f32x4){0.f, 0.f, 0.f, 0.f};
#pragma unroll
                    for (int ks = 0; ks < 4; ++ks) { const bf16x8 af = *(const LAS bf16x8*)(VNT + (drow + 4 * nt) * 272 + (32 * ks + 8 * fq) * 2);
                        z = __builtin_amdgcn_mfma_f32_16x16x32_bf16(af, wsf[ks], z, 0, 0, 0); }
#pragma unroll
                    for (int e = 0; e < 4; ++e) outv[4 * nt + e] += qs[4 * nt + e] * (z[e] + bsv);
                    }
            }
            {   const int ch = lane; float h = CARRY[par * 64 + ch];
                for (int w2 = 0; w2 < wid; ++w2) { const f32x2 s = SEG[w2 * 64 + ch]; h = s.x * h + s.y; }
                HIN[wid * 64 + ch] = h;
                if (wid == 7) { const f32x2 s = SEG[7 * 64 + ch]; CARRY[(par ^ 1) * 64 + ch] = s.x * h + s.y; }
            }
            if (more) {
                {   float sm = nS.x + nS.z, sq = nS.y + nS.w; sm += __shfl_xor(sm, 1); sq += __shfl_xor(sq, 1); sm += __shfl_xor(sm, 2); sq += __shfl_xor(sq, 2);
                    const float mean = sm * (1.f / 128.f), var = fmaxf(sq * (1.f / 128.f) - mean * mean, 0.f); if ((tid & 3) == 0) STAT[(par ^ 1) * 128 + (tid >> 2)] = (f32x2){mean, rsqrtf(var + EPS)}; }
                if (fr >= 13 && wid < 7) { LAS unsigned char* hp = lds + MX_PH + (((par ^ 1) * 9 + wid + 1) * 3 + (fr - 13)) * 128 + 32 * fq; LAS unsigned char* hx = hp + (MX_XH - MX_PH);
                    *(LAS u32x4*)hp = nP.a; *(LAS u32x4*)(hp + 16) = nP.b; *(LAS u32x4*)hx = nX.a; *(LAS u32x4*)(hx + 16) = nX.b; }
            }
            __syncthreads();
            {   float qr[16]; unpack16(cQR, qr);
#pragma unroll
                for (int q4 = 0; q4 < 4; ++q4) { const f32x4 hin = *(const LAS f32x4*)(HIN + wid * 64 + 16 * fq + 4 * q4);
#pragma unroll
                    for (int e = 0; e < 4; ++e) { const int i = 4 * q4 + e; outv[i] += qr[i] * (bv[i] + av[i] * hin[e]); } }
            }
            *(u32x4*)(MRG + moff) = (u32x4){cvt_pk_bf16(outv[0], outv[1]), cvt_pk_bf16(outv[2], outv[3]), cvt_pk_bf16(outv[4], outv[5]), cvt_pk_bf16(outv[6], outv[7])};
            *(u32x4*)(MRG + moff + 8) = (u32x4){cvt_pk_bf16(outv[8], outv[9]), cvt_pk_bf16(outv[10], outv[11]), cvt_pk_bf16(outv[12], outv[13]), cvt_pk_bf16(outv[14], outv[15])};
            cP = nP; cX = nX;
#pragma unroll
            for (int i = 0; i < 8; ++i) cV[i] = nV[i];
        }
    }
}

#define XB_TMO      128
#define XB_XCNT(j)  (256  + 64 * (j))
#define XB_XSUB(j)  (1280 + 64 * (j))
#define XB_XGEN(j)  (2304 + 64 * (j))
#define XB_TOP      3328
#define XB_TOPGEN   3392
#define XCD_BAR_WORDS 3456
#define XB_SPIN_CAP (1u << 18)

__device__ __forceinline__ unsigned xb_ld(unsigned* p)              { return __hip_atomic_load(p, __ATOMIC_RELAXED, __HIP_MEMORY_SCOPE_AGENT); }
__device__ __forceinline__ unsigned xb_add(unsigned* p, unsigned v) { return __hip_atomic_fetch_add(p, v, __ATOMIC_RELAXED, __HIP_MEMORY_SCOPE_AGENT); }
__device__ __forceinline__ unsigned xb_xcc_id() { return (unsigned)__builtin_amdgcn_s_getreg((3 << 11) | 20) & 0xFu; }
#define XB_SPIN(cond, bar) do { unsigned _sp = 0; while (cond) { __builtin_amdgcn_s_sleep(1); \
    if ((++_sp & 255u) == 0u) { if (xb_ld(&(bar)[XB_TMO])) break; if (_sp > XB_SPIN_CAP) { atomicAdd(&(bar)[XB_TMO], 1u); break; } } } } while (0)

struct XcdBarrier {
    unsigned* bar; unsigned x;
    volatile LAS unsigned* st;
};

__device__ __forceinline__ XcdBarrier xcd_barrier_post(unsigned* bar, volatile LAS unsigned* st) {
    XcdBarrier b; b.bar = bar; b.x = xb_xcc_id(); b.st = st;
    if (threadIdx.x == 0) (void)xb_add(&bar[XB_XCNT(b.x)], 1u);
    return b;
}
__device__ __forceinline__ void xcd_barrier_complete(unsigned* bar, unsigned x, unsigned& nloc, unsigned& nx) {
    const unsigned G = gridDim.x * gridDim.y * gridDim.z;
    unsigned sum, cnt, mine, sp = 0u;
    for (;;) {
        sum = 0u; cnt = 0u; mine = 0u;
#pragma unroll
        for (unsigned j = 0; j < 16; ++j) { const unsigned c = xb_ld(&bar[XB_XCNT(j)]); sum += c; cnt += (c > 0u) ? 1u : 0u; mine = (j == x) ? c : mine; }
        if (sum == G) break;
        __builtin_amdgcn_s_sleep(1);
        if ((++sp & 255u) == 0u) { if (xb_ld(&bar[XB_TMO])) break; if (sp > XB_SPIN_CAP) { atomicAdd(&bar[XB_TMO], 1u); break; } }
    }
    nloc = mine > 0u ? mine : 1u; nx = cnt > 0u ? cnt : 1u;
}

__device__ __forceinline__ void xcd_barrier(const XcdBarrier& b) {
    asm volatile("s_waitcnt vmcnt(0)" ::: "memory");
    __syncthreads();
    if (threadIdx.x == 0) {
        unsigned bx = b.x; asm volatile("" : "+s"(bx));
        unsigned* bar = b.bar; asm volatile("" : "+s"(bar));
        __builtin_amdgcn_s_waitcnt(0);
        unsigned nloc = b.st[0], nx = b.st[1];
        if (nloc == 0u) { xcd_barrier_complete(bar, bx, nloc, nx); b.st[0] = nloc; b.st[1] = nx; }
        const unsigned old = xb_add(&bar[XB_XSUB(bx)], 1u);
        const unsigned gen = old / nloc;
        if (old + 1u == (gen + 1u) * nloc) {
            __builtin_amdgcn_fence(__ATOMIC_RELEASE, "agent");
            asm volatile("s_waitcnt vmcnt(0)" ::: "memory");
            const unsigned og = xb_add(&bar[XB_TOP], 1u);
            const unsigned tg = og / nx;
            if (og + 1u == (tg + 1u) * nx) xb_add(&bar[XB_TOPGEN], 1u);
            else XB_SPIN(xb_ld(&bar[XB_TOPGEN]) == tg, bar);
            __builtin_amdgcn_fence(__ATOMIC_ACQUIRE, "agent");
            xb_add(&bar[XB_XGEN(bx)], 1u);
            asm volatile("s_waitcnt vmcnt(0)" ::: "memory");
        } else {
            XB_SPIN(xb_ld(&bar[XB_XGEN(bx)]) == gen, bar);
            __builtin_amdgcn_fence(__ATOMIC_ACQUIRE, "agent");
            asm volatile("s_waitcnt vmcnt(0)" ::: "memory");
        }
    }
    __syncthreads();
}


__global__ void __launch_bounds__(512, 2) __attribute__((target("no-packed-fp32-ops"))) fwd_megakernel(Args a) {
    extern __shared__ __attribute__((aligned(16))) unsigned char lds_raw[];
    LAS unsigned char* lds = (LAS unsigned char*)lds_raw;
    cg::grid_group grid = cg::this_grid();
    if (threadIdx.x == 0) {
        LAS unsigned long long* PT = (LAS unsigned long long*)(lds + PT_OFF);
        PT[0] = (unsigned long long)a.in[0]; PT[1] = (unsigned long long)a.in[1]; PT[2] = (unsigned long long)a.in[2]; PT[3] = (unsigned long long)a.in[3]; PT[4] = (unsigned long long)a.in[4];
        PT[5] = (unsigned long long)a.in[5]; PT[6] = (unsigned long long)a.in[6]; PT[7] = (unsigned long long)a.in[7]; PT[8] = (unsigned long long)a.in[8]; PT[9] = (unsigned long long)a.in[9];
        PT[10] = (unsigned long long)a.in[10]; PT[11] = (unsigned long long)a.in[11]; PT[12] = (unsigned long long)a.in[12]; PT[13] = (unsigned long long)a.in[13]; PT[14] = (unsigned long long)a.in[14];
        PT[15] = (unsigned long long)a.in[15]; PT[16] = (unsigned long long)a.in[16]; PT[17] = (unsigned long long)a.in[17]; PT[18] = (unsigned long long)a.out; PT[19] = (unsigned long long)a.ws;
    }
    if (threadIdx.x == 0) { *(LAS unsigned*)(lds + LDS_BARST) = 0u; *(LAS unsigned*)(lds + LDS_BARST + 4) = 0u; }
    __syncthreads();
    const int G = gridDim.x;
    {   pg8::StaticOrder S1; S1.init(M, NIN, G, (int)blockIdx.x); pm_slots_init(lds, S1); }
    const XcdBarrier bar = xcd_barrier_post((unsigned*)(a.ws + WS_CTL), (volatile LAS unsigned*)(lds + LDS_BARST));

    p0_prologue(lds);
    grid.sync();
    p1_prologue(lds);
    xcd_barrier(bar);
    for (int l = 0; l < DEPTH; ++l) {
        {   unsigned char* ws = getp<unsigned char>(lds, I_WS);
            pg8::Gemm g{(const bf16_t*)(ws + WS_H), (const bf16_t*)(ws + WS_WIN) + (size_t)l * NIN * D, M, NIN, D};
            pg8::StaticOrder S; S.init(M, NIN, G, (int)blockIdx.x);
            rstd_prelude(lds, (const float*)(ws + WS_RSS));
            EpiG1 E{lds, l};
            pg8::gemm_phase<EpiG1, true>(lds, g, S, E); }
        if (blockIdx.x < 256) mixer_fill(lds, l, mixer_unit_of((int)blockIdx.x));
        xcd_barrier(bar);
        mixer_phase(lds, l);
        xcd_barrier(bar);
        {   unsigned char* ws = getp<unsigned char>(lds, I_WS);
            pg8::Gemm g{(const bf16_t*)(ws + WS_MRG), (const bf16_t*)(ws + WS_WOUT) + (size_t)l * D * D, M, D, D};
            pg8::StaticOrder S; S.init(M, D, G, (int)blockIdx.x);
            EpiG2 E{lds, l};
            pg8::gemm_phase<EpiG2, false>(lds, g, S, E); }
        xcd_barrier(bar);
    }
    final_norm(getp<float>(lds, I_OUT), getp<const float>(lds, I_FG));
}

extern "C" void kernel_launch(void* const* d_in, const int* in_sizes, int n_in, void* d_out, int out_size, void* d_ws, size_t ws_size, hipStream_t stream) {
    static int grid = 0;
    if (grid == 0) {
        if (n_in != 18 || in_sizes[0] != M * D || out_size != M * D || ws_size < WS_END) { fprintf(stderr, "kernel_launch: unexpected shapes (n_in %d, in0 %d, out %d, ws %zu)\n", n_in, n_in > 0 ? in_sizes[0] : -1, out_size, ws_size); grid = -1; return; }
        int dev = 0, cus = 0, per_cu = 0;
        if (hipGetDevice(&dev) != hipSuccess || hipDeviceGetAttribute(&cus, hipDeviceAttributeMultiprocessorCount, dev) != hipSuccess) { fprintf(stderr, "kernel_launch: device query failed\n"); grid = -1; return; }
        if (hipFuncSetAttribute((const void*)fwd_megakernel, hipFuncAttributeMaxDynamicSharedMemorySize, LDS_BYTES) != hipSuccess) { fprintf(stderr, "kernel_launch: hipFuncSetAttribute failed\n"); grid = -1; return; }
        if (hipOccupancyMaxActiveBlocksPerMultiprocessor(&per_cu, (const void*)fwd_megakernel, 512, LDS_BYTES) != hipSuccess || per_cu < 1) { fprintf(stderr, "kernel_launch: occupancy query says %d blocks per CU\n", per_cu); per_cu = 1; }
        (void)hipGetLastError();
        grid = cus * per_cu;
    }
    if (grid < 0) return;
    if (hipMemsetAsync((char*)d_ws + WS_CTL, 0, CTL_BYTES, stream) != hipSuccess) { fprintf(stderr, "kernel_launch: memset of the barrier words failed\n"); return; }
    Args a{};
    for (int i = 0; i < 18; ++i) a.in[i] = (const float*)d_in[i];
    a.out = (float*)d_out; a.ws = (unsigned char*)d_ws;
    void* args[] = {&a};
    const hipError_t e = hipLaunchCooperativeKernel((const void*)fwd_megakernel, dim3(grid), dim3(512), args, LDS_BYTES, stream);
    if (e != hipSuccess) fprintf(stderr, "kernel_launch: cooperative launch failed: %s (grid %d)\n", hipGetErrorString(e), grid);
}
```

```cpp
#include <hip/hip_runtime.h>
#include <hip/hip_cooperative_groups.h>
#include <cstdio>
#include <cstdint>
namespace cg = cooperative_groups;

#define LAS __attribute__((address_space(3)))
typedef unsigned short bf16_t;
typedef short bf16x8 __attribute__((ext_vector_type(8)));
typedef float f32x4 __attribute__((ext_vector_type(4)));
typedef float f32x2 __attribute__((ext_vector_type(2)));
typedef unsigned u32x4 __attribute__((ext_vector_type(4)));
typedef unsigned u32x2 __attribute__((ext_vector_type(2)));

constexpr int D = 1024, NB = 16, SEQ = 2048, M = NB * SEQ, DEPTH = 4, NIN = 12288;
constexpr float EPS = 1e-6f;
constexpr size_t MiB = 1u << 20;
constexpr size_t WS_WIN = 0;
constexpr size_t WS_WOUT = 96 * MiB;
constexpr size_t WS_WSB = 104 * MiB;
constexpr size_t WS_WA = 105 * MiB;
constexpr size_t WS_WX = 105 * MiB + 512 * 1024;
constexpr size_t WS_MOD = 106 * MiB;
constexpr size_t WS_H = 112 * MiB;
constexpr size_t WS_MRG = 176 * MiB;
constexpr size_t WS_P = 240 * MiB, WS_QA = 304 * MiB, WS_V = 368 * MiB, WS_QS = 432 * MiB, WS_XR = 496 * MiB, WS_QR = 560 * MiB, WS_SGA = 624 * MiB;
constexpr size_t WS_VST = 688 * MiB;
constexpr size_t WS_RSS = 704 * MiB;
constexpr size_t WS_BIAS = 107 * MiB;
constexpr size_t WS_GP = 110 * MiB;
constexpr size_t WS_CTL = 706 * MiB, CTL_BYTES = 16384;
constexpr size_t WS_END = 707 * MiB;
constexpr int LDS_BYTES = 147456;
constexpr int LDS_RSTD = 133120, LDS_PMS = 141312, LDS_BIAS = 141440, LDS_BARST = 142464, LDS_PMLIST = 142480;

typedef __bf16 bf16x2_t __attribute__((ext_vector_type(2)));
__device__ __forceinline__ unsigned cvt_pk_bf16(float lo, float hi) { const bf16x2_t r = __builtin_convertvector((f32x2){lo, hi}, bf16x2_t); return __builtin_bit_cast(unsigned, r); }
__device__ __forceinline__ float bflo(unsigned u) { return __uint_as_float(u << 16); }
__device__ __forceinline__ float bfhi(unsigned u) { return __uint_as_float(u & 0xffff0000u); }
__device__ __forceinline__ float sigm(float z) { return __builtin_amdgcn_rcpf(1.f + __expf(-z)); }
__device__ __forceinline__ float rows_sum(float v) {
    float a = v, b = v; asm volatile("s_nop 1\n v_permlane16_swap_b32 %0, %1" : "+v"(a), "+v"(b)); const float s = a + b;
    float c = s, d = s; asm volatile("s_nop 1\n v_permlane32_swap_b32 %0, %1" : "+v"(c), "+v"(d)); return c + d;
}
__device__ __forceinline__ float wave_sum(float v) {
#pragma unroll
    for (int o = 1; o < 64; o <<= 1) v += __shfl_xor(v, o);
    return v;
}

struct Args { const float* in[18]; float* out; unsigned char* ws; };
enum { I_X = 0, I_C, I_GAIN, I_WMOD, I_BMOD, I_WIN, I_WOUT, I_CAW, I_SW, I_SB, I_LCW, I_LCB, I_WA, I_BA, I_WX, I_BX, I_LAM, I_FG, I_OUT, I_WS };
constexpr int PT_OFF = 131072 + 1024;
template <class T> __device__ __forceinline__ T* getp(LAS unsigned char* lds, int i) {
    int off = PT_OFF + 8 * i; asm volatile("" : "+v"(off));
    const u32x2 v = *(volatile LAS u32x2*)(lds + off);
    const unsigned lo = __builtin_amdgcn_readfirstlane(v.x), hi = __builtin_amdgcn_readfirstlane(v.y);
    return (T*)(__attribute__((address_space(1))) T*)(((unsigned long long)hi << 32) | (unsigned long long)lo);
}
__device__ __forceinline__ int launder(int v) { asm volatile("" : "+v"(v)); return v; }

namespace pg8 {
constexpr int BM = 256, BK = 64, HALF = 128, HTB = HALF * BK * 2, STAGE_BYTES = 8 * HTB, NXCD = 8, WGM = 8;
__host__ __device__ __forceinline__ int lds_byte(int r, int c) { const int st = (r >> 4) * 2 + (c >> 5), rr = r & 15, cc = c & 31, ob = rr * 64 + cc * 2; return st * 1024 + (ob ^ (((ob >> 9) & 1) << 5)); }
__host__ __device__ __forceinline__ void stage_rc(int b, int& R, int& C) { const int st = b / 1024, sb = b % 1024, swz = sb ^ (((sb >> 9) & 1) << 5); R = (st >> 1) * 16 + swz / 64; C = (st & 1) * 32 + (swz % 64) / 2; }

struct Unit { int pm, pn; };
struct Gemm { const bf16_t* A; const bf16_t* Bt; int M, N, K; };

struct StaticOrder {
    int nM, nN, nwg, G, c;
    __host__ __device__ __forceinline__ void init(int M_, int N_, int G_, int c_) { nM = M_ / BM; nN = N_ / BM; nwg = nM * nN; G = G_; c = c_; }
    __host__ __device__ __forceinline__ bool next(int i, Unit& u) const {
        const long L = (long)i * G + c; if (L >= nwg) return false;
        int wgid = (int)L; { const int q = nwg / NXCD, r = nwg % NXCD, xcd = wgid % NXCD, off = wgid / NXCD; wgid = (xcd < r ? xcd * (q + 1) : r * (q + 1) + (xcd - r) * q) + off; }
        const int nig = WGM * nN, gid = wgid / nig, fm = gid * WGM, gsz = (nM - fm) < WGM ? (nM - fm) : WGM;
        u.pm = fm + ((wgid % nig) % gsz); u.pn = (wgid % nig) / gsz; return true;
    }
};

template <class Epi, bool SEG, bool ALIGN_EPI = true, bool SP2 = true>
__device__ __forceinline__ void gemm_phase(LAS unsigned char* lds, const Gemm g, const StaticOrder& S, const Epi& E) {
    const int tid = launder(threadIdx.x), wid = __builtin_amdgcn_readfirstlane(tid >> 6), lane = tid & 63, wr = wid >> 2, wc = wid & 3, fr = lane & 15, fq = lane >> 4;
    const int K = g.K, nt = K / BK;
    unsigned voffA[2], voffB[2];
#pragma unroll
    for (int i = 0; i < 2; ++i) { int R, C; stage_rc(tid * 16 + i * 8192, R, C);
        const int Rb = SEG ? (((R >> 4) & 1) * 1024 + 16 * (R >> 5) + (R & 15)) : ((R & ~31) + 8 * ((R & 15) >> 2) + 4 * ((R >> 4) & 1) + (R & 3));
        voffA[i] = (unsigned)(R * K + C) * 2u; voffB[i] = (unsigned)(Rb * K + C) * 2u; }
    const size_t kstep = (size_t)(BK * 2);
    const size_t hstep = (size_t)HALF * K * 2;
    const size_t tstep = 2 * hstep;
    const size_t hstepB = SEG ? (size_t)2048 * K * 2 : hstep;
    const unsigned ldsw = (unsigned)wid * 1024u;
    const int aoff = lds_byte(wr * 64 + fr, fq * 8), boff = lds_byte(wc * 32 + fr, fq * 8);
#define PG8_BBASE(pn) (SEG ? ((size_t)(((pn) >> 4) * 4096 + ((pn) & 15) * 64) * K * 2) : ((size_t)(pn) * tstep))
#define PG8_SA(b, h) (((b) * 2 + (h)) * HTB)
#define PG8_SB(b, h) ((4 + (b) * 2 + (h)) * HTB)
#define PG8_STAGE(bufoff, gbase, voff) do { _Pragma("unroll") for (int _i = 0; _i < 2; ++_i) \
        __builtin_amdgcn_global_load_lds((const unsigned*)((const char*)(gbase) + (voff)[_i]), (LAS unsigned*)(lds + (bufoff) + ldsw + _i * 8192), 16, 0, 0); } while (0)
#define PG8_LDA(dst, b, h) do { _Pragma("unroll") for (int m = 0; m < 4; ++m) _Pragma("unroll") for (int k = 0; k < 2; ++k) dst[m][k] = *(const LAS bf16x8*)(lds + PG8_SA(b, h) + aoff + m * 2048 + k * 1024); } while (0)
#define PG8_LDB(dst, b, h) do { _Pragma("unroll") for (int n = 0; n < 2; ++n) _Pragma("unroll") for (int k = 0; k < 2; ++k) dst[n][k] = *(const LAS bf16x8*)(lds + PG8_SB(b, h) + boff + n * 2048 + k * 1024); } while (0)
#define PG8_MMA(ai, bj, At, Bt) do { __builtin_amdgcn_s_setprio(1); _Pragma("unroll") for (int m = 0; m < 4; ++m) _Pragma("unroll") for (int n = 0; n < 2; ++n) _Pragma("unroll") for (int k = 0; k < 2; ++k) \
        acc[ai][bj][m][n] = __builtin_amdgcn_mfma_f32_16x16x32_bf16(Bt[n][k], At[m][k], acc[ai][bj][m][n], 0, 0, 0); __builtin_amdgcn_s_setprio(0); } while (0)
#define PG8_WAIT_V(n) asm volatile("s_waitcnt vmcnt(" #n ")" ::: "memory")
#define PG8_WAIT_L(n) asm volatile("s_waitcnt lgkmcnt(" #n ")" ::: "memory")
#define PG8_BAR __builtin_amdgcn_s_barrier()
#define PG8_SCHED __builtin_amdgcn_sched_barrier(0)
    Unit cur, nxt; int ui = 0;
    if (!S.next(0, cur)) return;
    f32x4 acc[2][2][4][2];
#pragma unroll
    for (int a = 0; a < 2; ++a)
#pragma unroll
        for (int b = 0; b < 2; ++b)
#pragma unroll
            for (int m = 0; m < 4; ++m)
#pragma unroll
                for (int n = 0; n < 2; ++n) acc[a][b][m][n] = (f32x4){0.f, 0.f, 0.f, 0.f};
    bf16x8 At[4][2], B0[2][2], B1[2][2];
    const char* cA = (const char*)g.A + (size_t)cur.pm * tstep; const char* cB = (const char*)g.Bt + PG8_BBASE(cur.pn);
    if constexpr (SP2) {
        PG8_STAGE(PG8_SB(0, 0), cB, voffB); PG8_STAGE(PG8_SB(0, 1), cB + hstepB, voffB); PG8_STAGE(PG8_SA(0, 0), cA, voffA); PG8_STAGE(PG8_SA(0, 1), cA + hstep, voffA);
        if (wr == 1) PG8_BAR;
        PG8_WAIT_V(2); PG8_BAR;
        PG8_STAGE(PG8_SB(1, 0), cB + kstep, voffB); PG8_STAGE(PG8_SA(1, 0), cA + kstep, voffA); PG8_STAGE(PG8_SB(1, 1), cB + hstepB + kstep, voffB);
        PG8_WAIT_V(6); PG8_BAR;
    } else {
        PG8_STAGE(PG8_SB(0, 0), cB, voffB); PG8_STAGE(PG8_SA(0, 0), cA, voffA); PG8_STAGE(PG8_SB(0, 1), cB + hstepB, voffB); PG8_STAGE(PG8_SA(0, 1), cA + hstep, voffA);
        if (wr == 1) PG8_BAR;
        PG8_WAIT_V(4); PG8_BAR;
        PG8_STAGE(PG8_SB(1, 0), cB + kstep, voffB); PG8_STAGE(PG8_SA(1, 0), cA + kstep, voffA); PG8_STAGE(PG8_SB(1, 1), cB + hstepB + kstep, voffB);
        PG8_WAIT_V(6); PG8_BAR;
    }
    for (;;) {
        const bool has_next = S.next(ui + 1, nxt);
        const char* nA = has_next ? (const char*)g.A + (size_t)nxt.pm * tstep : cA; const char* nB = has_next ? (const char*)g.Bt + PG8_BBASE(nxt.pn) : cB;
        static_assert(SP2, "this build keeps only the two-super-phase K-loop");
#define PG8_KBODY(t, last) do { \
            const char* a1 = cA + (size_t)((t) + 1) * kstep; \
            const char* a2 = (last) ? nA : cA + (size_t)((t) + 2) * kstep; const char* b2 = (last) ? nB : cB + (size_t)((t) + 2) * kstep; \
            const char* a3 = a2 + kstep; const char* b3 = b2 + kstep; \
            PG8_LDB(B0, 0, 0); PG8_LDB(B1, 0, 1); PG8_SCHED; PG8_LDA(At, 0, 0); PG8_STAGE(PG8_SA(1, 1), a1 + hstep, voffA); \
            PG8_WAIT_V(8); PG8_WAIT_L(0); PG8_BAR; PG8_MMA(0, 0, At, B0); PG8_MMA(0, 1, At, B1); PG8_BAR; PG8_SCHED; \
            PG8_LDA(At, 0, 1); PG8_STAGE(PG8_SB(0, 0), b2, voffB); PG8_STAGE(PG8_SB(0, 1), b2 + hstepB, voffB); PG8_STAGE(PG8_SA(0, 0), a2, voffA); \
            PG8_WAIT_V(8); PG8_WAIT_L(0); PG8_BAR; PG8_MMA(1, 0, At, B0); PG8_MMA(1, 1, At, B1); PG8_BAR; PG8_SCHED; \
            PG8_LDB(B0, 1, 0); PG8_LDB(B1, 1, 1); PG8_SCHED; PG8_LDA(At, 1, 0); PG8_STAGE(PG8_SA(0, 1), a2 + hstep, voffA); \
            PG8_WAIT_V(8); PG8_WAIT_L(0); PG8_BAR; PG8_MMA(0, 0, At, B0); PG8_MMA(0, 1, At, B1); PG8_BAR; PG8_SCHED; \
            PG8_LDA(At, 1, 1); PG8_STAGE(PG8_SB(1, 0), b3, voffB); PG8_STAGE(PG8_SB(1, 1), b3 + hstepB, voffB); PG8_STAGE(PG8_SA(1, 0), a3, voffA); \
            PG8_WAIT_V(8); PG8_WAIT_L(0); PG8_BAR; PG8_MMA(1, 0, At, B0); PG8_MMA(1, 1, At, B1); PG8_BAR; PG8_SCHED; } while (0)
        for (int t = 0; t < nt; t += 2) { const bool last = (t == nt - 2);
            if (last) E.prefetch(cur, wid, lane);
            PG8_KBODY(t, last); }
#undef PG8_KBODY
        if constexpr (ALIGN_EPI) { if (wr == 0) PG8_BAR; }
        E(acc, cur, wr, wc, fr, fq);
        if (!has_next) break;
#pragma unroll
        for (int a = 0; a < 2; ++a)
#pragma unroll
            for (int b = 0; b < 2; ++b)
#pragma unroll
                for (int m = 0; m < 4; ++m)
#pragma unroll
                    for (int n = 0; n < 2; ++n) acc[a][b][m][n] = (f32x4){0.f, 0.f, 0.f, 0.f};
        cur = nxt; cA = nA; cB = nB; ++ui;
        if constexpr (ALIGN_EPI) { if (wr == 1) PG8_BAR; }
    }
    PG8_WAIT_V(0);
    if constexpr (!ALIGN_EPI) { if (wr == 0) PG8_BAR; }
    PG8_BAR;
#undef PG8_BBASE
#undef PG8_SA
#undef PG8_SB
#undef PG8_STAGE
#undef PG8_LDA
#undef PG8_LDB
#undef PG8_MMA
#undef PG8_WAIT_V
#undef PG8_WAIT_L
#undef PG8_BAR
#undef PG8_SCHED
}
}

struct EpiG1 {
    LAS unsigned char* lds; int l;
    __device__ __forceinline__ void prefetch(const pg8::Unit& u, int wid, int lane) const {
        if (wid == 0) { const float* bias = (const float*)(getp<unsigned char>(lds, I_WS) + WS_BIAS) + (size_t)l * 16 * NIN; lane = launder(lane);
            const float* src = bias + (size_t)(u.pm >> 3) * NIN + (u.pn >> 4) * 4096 + (u.pn & 15) * 64 + (lane >> 4) * 1024 + (lane & 15) * 4;
            __builtin_amdgcn_global_load_lds((const unsigned*)src, (LAS unsigned*)(lds + LDS_BIAS), 16, 0, 0); }
    }
    static __device__ __forceinline__ void rowswap(unsigned& x, unsigned& y) { asm volatile("s_nop 1\n v_permlane16_swap_b32 %0, %1" : "+v"(x), "+v"(y)); }
    template <int TT> __device__ __forceinline__ void body(const f32x4 (&acc)[2][2][4][2], const pg8::Unit& u, int wr, int wc, int fr_, int fq_) const {
        const int fr = launder(fr_), fq = launder(fq_);
        unsigned char* ws = getp<unsigned char>(lds, I_WS);
        const int cb = u.pn & 15;
        const int slot = __builtin_amdgcn_readfirstlane((int)*(const LAS unsigned char*)(lds + LDS_PMS + u.pm));
        const LAS float* rs = (const LAS float*)(lds + LDS_RSTD) + slot * 256 + wr * 64 + fr;
        const LAS float* bl = (const LAS float*)(lds + LDS_BIAS) + wc * 16 + fq * 4;
        const int par = fq & 1, hq = fq >> 1;
        bf16_t* Asel = (bf16_t*)(ws + (TT == 0 ? WS_P : TT == 1 ? WS_V : WS_XR) + (size_t)par * (64 * MiB));
        bf16_t* SGA = (bf16_t*)(ws + WS_SGA); float* VST = (float*)(ws + WS_VST);
        const f32x4 bs0 = *(const LAS f32x4*)bl, bs1 = *(const LAS f32x4*)(bl + 64), bs2 = *(const LAS f32x4*)(bl + 128), bs3 = *(const LAS f32x4*)(bl + 192);
        const int chblk = cb * 4 + wc;
#pragma unroll
        for (int ai = 0; ai < 2; ++ai) {
            const int rb0 = u.pm * 16 + ai * 8 + wr * 4;
            u32x2 sgprev = (u32x2){0u, 0u}; float smprev = 0.f, sqprev = 0.f;
#pragma unroll
            for (int m = 0; m < 4; ++m) {
                const float rstd = rs[ai * 128 + m * 16];
                const f32x4 s0 = acc[ai][0][m][0] * rstd + bs0, s1 = acc[ai][0][m][1] * rstd + bs1, s2 = acc[ai][1][m][0] * rstd + bs2, s3 = acc[ai][1][m][1] * rstd + bs3;
                u32x2 a0, a1;
                if constexpr (TT == 0) {
                    f32x4 p, q;
#pragma unroll
                    for (int e = 0; e < 4; ++e) { p[e] = s2[e] * s0[e]; q[e] = s3[e] * sigm(s3[e]) * s1[e]; }
                    a0 = (u32x2){cvt_pk_bf16(p[0], p[1]), cvt_pk_bf16(p[2], p[3])}; a1 = (u32x2){cvt_pk_bf16(q[0], q[1]), cvt_pk_bf16(q[2], q[3])};
                } else if constexpr (TT == 1) {
                    f32x4 q;
#pragma unroll
                    for (int e = 0; e < 4; ++e) q[e] = (s2[e] * s0[e]) * __builtin_amdgcn_rcpf((1.f + __expf(-s2[e])) * (1.f + __expf(-s3[e])));
                    a0 = (u32x2){cvt_pk_bf16(s1[0], s1[1]), cvt_pk_bf16(s1[2], s1[3])}; a1 = (u32x2){cvt_pk_bf16(q[0], q[1]), cvt_pk_bf16(q[2], q[3])};
                    const float smm = rows_sum((s1[0] + s1[1]) + (s1[2] + s1[3])), sqm = rows_sum((s1[0] * s1[0] + s1[1] * s1[1]) + (s1[2] * s1[2] + s1[3] * s1[3]));
                    if ((m & 1) == 0) { smprev = smm; sqprev = sqm; }
                    else if (hq == 0) {
                        *(f32x2*)(VST + ((((size_t)(rb0 + m - 1 + par) * 8 + (cb >> 1)) * 8 + (cb & 1) * 4 + wc) * 16 + fr) * 2) = par ? (f32x2){smm, sqm} : (f32x2){smprev, sqprev}; }
                } else {
                    f32x4 q, g;
#pragma unroll
                    for (int e = 0; e < 4; ++e) { q[e] = s1[e] * __builtin_amdgcn_rcpf((1.f + __expf(-s1[e])) * (1.f + __expf(-s2[e]))); g[e] = sigm(s3[e]); }
                    a0 = (u32x2){cvt_pk_bf16(s0[0], s0[1]), cvt_pk_bf16(s0[2], s0[3])}; a1 = (u32x2){cvt_pk_bf16(q[0], q[1]), cvt_pk_bf16(q[2], q[3])};
                    const u32x2 sgm = (u32x2){cvt_pk_bf16(g[0], g[1]), cvt_pk_bf16(g[2], g[3])};
                    if ((m & 1) == 0) sgprev = sgm;
                    else {
                        unsigned xx = sgprev.x, xy = sgprev.y, yx = sgm.x, yy = sgm.y; rowswap(xx, yx); rowswap(xy, yy);
                        const size_t so = ((size_t)((rb0 + m - 1 + par) * 64 + chblk)) * 256 + fr * 16 + 8 * hq;
                        __builtin_nontemporal_store((u32x4){xx, xy, yx, yy}, (u32x4*)(SGA + so)); }
                }
                unsigned a0x = a0.x, a0y = a0.y, a1x = a1.x, a1y = a1.y;
                rowswap(a0x, a1x); rowswap(a0y, a1y);
                const size_t off = ((size_t)((rb0 + m) * 64 + chblk)) * 256 + fr * 16 + 8 * hq;
                __builtin_nontemporal_store((u32x4){a0x, a0y, a1x, a1y}, (u32x4*)(Asel + off));
            }
        }
    }
    __device__ __forceinline__ void operator()(const f32x4 (&acc)[2][2][4][2], const pg8::Unit& u, int wr, int wc, int fr, int fq) const {
        const int tt = u.pn >> 4;
        if (tt == 0) body<0>(acc, u, wr, wc, fr, fq); else if (tt == 1) body<1>(acc, u, wr, wc, fr, fq); else body<2>(acc, u, wr, wc, fr, fq);
    }
};
struct EpiG2 {
    LAS unsigned char* lds; int l;
    __device__ __forceinline__ void prefetch(const pg8::Unit&, int, int) const {}
    __device__ __forceinline__ void operator()(const f32x4 (&acc)[2][2][4][2], const pg8::Unit& u, int wr, int wc, int fr_, int fq_) const {
        const int fr = launder(fr_), fq = launder(fq_);
        unsigned char* ws = getp<unsigned char>(lds, I_WS); float* xout = getp<float>(lds, I_OUT);
        const float* xin = (l == 0) ? getp<const float>(lds, I_X) : (const float*)xout;
        const float* gate = (const float*)(ws + WS_MOD) + (size_t)l * 16 * 3072 + 2048;
        const int do_next = l < DEPTH - 1 ? 1 : 0;
        const float* gp = (const float*)(ws + WS_GP) + (size_t)(do_next ? l + 1 : l) * 16 * D; bf16_t* H = (bf16_t*)(ws + WS_H); float* RSS = (float*)(ws + WS_RSS);
        const int b = u.pm >> 3, col0 = u.pn * 256 + wc * 32 + 8 * fq;
        f32x4 gv[2][2], pv[2][2];
#pragma unroll
        for (int bj = 0; bj < 2; ++bj)
#pragma unroll
            for (int n = 0; n < 2; ++n) { gv[bj][n] = *(const f32x4*)(gate + (size_t)b * 3072 + col0 + bj * 128 + n * 4);
                pv[bj][n] = *(const f32x4*)(gp + (size_t)b * D + col0 + bj * 128 + n * 4); }
#pragma unroll
        for (int ai = 0; ai < 2; ++ai)
#pragma unroll
            for (int m = 0; m < 4; ++m) {
                const int row = u.pm * 256 + ai * 128 + wr * 64 + m * 16 + fr;
                const size_t off = (size_t)row * D + col0;
                float ss = 0.f;
#pragma unroll
                for (int bj = 0; bj < 2; ++bj) {
                    const f32x4 x0 = *(const f32x4*)(xin + off + bj * 128), x1 = *(const f32x4*)(xin + off + bj * 128 + 4);
                    const f32x4 o0 = x0 + gv[bj][0] * acc[ai][bj][m][0], o1 = x1 + gv[bj][1] * acc[ai][bj][m][1];
                    *(f32x4*)(xout + off + bj * 128) = o0; *(f32x4*)(xout + off + bj * 128 + 4) = o1;
                    if (do_next) { ss += ((o0.x * o0.x + o0.y * o0.y) + (o0.z * o0.z + o0.w * o0.w)) + ((o1.x * o1.x + o1.y * o1.y) + (o1.z * o1.z + o1.w * o1.w));
                        const f32x4 h0 = o0 * pv[bj][0], h1 = o1 * pv[bj][1];
                        *(u32x4*)(H + off + bj * 128) = (u32x4){cvt_pk_bf16(h0.x, h0.y), cvt_pk_bf16(h0.z, h0.w), cvt_pk_bf16(h1.x, h1.y), cvt_pk_bf16(h1.z, h1.w)}; }
                }
                if (do_next) { ss = rows_sum(ss); if (fq == 0) RSS[(size_t)row * 16 + u.pn * 4 + wc] = ss; }
            }
    }
};

__device__ __forceinline__ void pm_slots_init(LAS unsigned char* lds, const pg8::StaticOrder& S) {
    const int tid = launder(threadIdx.x);
    LAS unsigned char* PMS = lds + LDS_PMS; LAS unsigned char* LIST = lds + LDS_PMLIST;
    if (tid < 128) PMS[tid] = (unsigned char)0xFF;
    __syncthreads();
    if (tid == 0) { int ns = 0; pg8::Unit u; for (int i = 0; S.next(i, u); ++i) if (PMS[u.pm] == 0xFF && ns < 8) { PMS[u.pm] = (unsigned char)ns; LIST[ns] = (unsigned char)u.pm; ++ns; } LIST[8] = (unsigned char)ns; }
    __syncthreads();
}
__device__ __forceinline__ void rstd_prelude(LAS unsigned char* lds, const float* RSS) {
    const int tid = launder(threadIdx.x);
    LAS unsigned char* LIST = lds + LDS_PMLIST; LAS float* RSTD = (LAS float*)(lds + LDS_RSTD);
    const int nslots = __builtin_amdgcn_readfirstlane((int)LIST[8]);
    for (int slot = 0; slot < nslots; ++slot) {
        const int pm = __builtin_amdgcn_readfirstlane((int)LIST[slot]);
        {   const int r = tid >> 1, hf = tid & 1; const f32x4* p = (const f32x4*)(RSS + (size_t)(pm * 256 + r) * 16 + hf * 8); const f32x4 a = p[0], c = p[1];
            float ss = ((a.x + a.y) + (a.z + a.w)) + ((c.x + c.y) + (c.z + c.w)); ss += __shfl_xor(ss, 1);
            if (hf == 0) RSTD[slot * 256 + r] = rsqrtf(ss * (1.f / D) + EPS); }
    }
    __syncthreads();
}

__device__ __forceinline__ void p0_transpose_item(const float* W, int K, int N, bf16_t* WT, int kb, int n0, int drow0, LAS float* scr, int lane) {
    const int k0 = 64 * kb;
    float tv[32];
#pragma unroll
    for (int i = 0; i < 32; ++i) tv[i] = W[(size_t)(k0 + 2 * i + (lane >> 5)) * N + n0 + (lane & 31)];
#pragma unroll
    for (int i = 0; i < 32; ++i) scr[(2 * i + (lane >> 5)) * 33 + (lane & 31)] = tv[i];
    asm volatile("s_waitcnt lgkmcnt(0)" ::: "memory");
    const int c = lane & 7;
#pragma unroll
    for (int j = 0; j < 4; ++j) { const int n = (lane >> 3) + 8 * j; const LAS float* s = scr + (8 * c) * 33 + n;
        u32x4 o; o.x = cvt_pk_bf16(s[0 * 33], s[1 * 33]); o.y = cvt_pk_bf16(s[2 * 33], s[3 * 33]); o.z = cvt_pk_bf16(s[4 * 33], s[5 * 33]); o.w = cvt_pk_bf16(s[6 * 33], s[7 * 33]);
        *(u32x4*)(WT + (size_t)(drow0 + n) * K + k0 + 8 * c) = o; }
    asm volatile("s_waitcnt lgkmcnt(0)" ::: "memory");
}

__device__ __forceinline__ void p0_prologue(LAS unsigned char* lds) {
    const int tid = launder(threadIdx.x), wid = tid >> 6, lane = tid & 63, G = gridDim.x;
    unsigned char* ws = getp<unsigned char>(lds, I_WS);
    const float* in_c = getp<const float>(lds, I_C); const float* in_wmod = getp<const float>(lds, I_WMOD); const float* in_bmod = getp<const float>(lds, I_BMOD);
    {
        LAS float* CA = (LAS float*)lds; LAS float* RED = (LAS float*)(lds + 65536);
        float* MOD = (float*)(ws + WS_MOD);
        for (int u = blockIdx.x; u < 192; u += G) {
            __syncthreads();
            for (int i = tid; i < NB * D; i += 512) { const float v = in_c[i]; CA[i] = v * sigm(v); }
            __syncthreads();
            const int l = u / 48, j0 = (u % 48) * 64;
            const float* wp = in_wmod + (size_t)l * D * 3072 + j0 + lane;
            float acc[16];
#pragma unroll
            for (int b = 0; b < 16; ++b) acc[b] = 0.f;
            for (int k = 128 * wid; k < 128 * wid + 128; k += 16) {
                float wv[16];
#pragma unroll
                for (int q = 0; q < 16; ++q) wv[q] = wp[(size_t)(k + q) * 3072];
#pragma unroll
                for (int q = 0; q < 16; q += 4)
#pragma unroll
                    for (int b = 0; b < 16; ++b) { const f32x4 cv = *(const LAS f32x4*)(CA + b * D + k + q); acc[b] += (cv.x * wv[q] + cv.y * wv[q + 1]) + (cv.z * wv[q + 2] + cv.w * wv[q + 3]); }
            }
#pragma unroll
            for (int b = 0; b < 16; ++b) RED[(wid * 16 + b) * 64 + lane] = acc[b];
            __syncthreads();
            for (int o = tid; o < 1024; o += 512) { const int b = o >> 6, ci = o & 63; float s = in_bmod[l * 3072 + j0 + ci];
#pragma unroll
                for (int w = 0; w < 8; ++w) s += RED[(w * 16 + b) * 64 + ci];
                MOD[(size_t)(l * 16 + b) * 3072 + j0 + ci] = s; }
        }
        __syncthreads();
    }
    {
        LAS float* scr = (LAS float*)(lds + wid * 16384);
        const int gw = blockIdx.x * 8 + wid, NGW = G * 8;
        const float* in_win = getp<const float>(lds, I_WIN); const float* in_wout = getp<const float>(lds, I_WOUT);
        constexpr int I_IN = 16 * 384, I_OUT = 16 * 32, I_L = I_IN + I_OUT;
        for (int it = gw; it < DEPTH * I_L; it += NGW) {
            const int l = it / I_L; int r = it % I_L;
            if (r < I_IN) { const int kb = r / 384, nb = r % 384, n0 = nb * 32, sseg = n0 >> 10;
                const int dseg = (int)((0xA7B986543210ULL >> (4 * sseg)) & 15ULL);
                p0_transpose_item(in_win + (size_t)l * D * NIN, D, NIN, (bf16_t*)(ws + WS_WIN) + (size_t)l * NIN * D, kb, n0, dseg * 1024 + (n0 & 1023), scr, lane);
            } else { r -= I_IN; const int kb = r / 32, nb = r % 32;
                p0_transpose_item(in_wout + (size_t)l * D * D, D, D, (bf16_t*)(ws + WS_WOUT) + (size_t)l * D * D, kb, nb * 32, nb * 32, scr, lane); }
        }
    }
    {
        const int gt = blockIdx.x * 512 + tid, NT = G * 512;
        const float* in_sw = getp<const float>(lds, I_SW); const float* in_wa = getp<const float>(lds, I_WA); const float* in_wx = getp<const float>(lds, I_WX);
        bf16_t* WSB = (bf16_t*)(ws + WS_WSB);
        for (int i = gt; i < DEPTH * 8 * 128 * 128 / 2; i += NT) { const int e0 = 2 * i, t = (e0 >> 7) & 127, s = e0 & 127; const f32x2 v = *(const f32x2*)(in_sw + e0);
            *(unsigned*)(WSB + e0) = cvt_pk_bf16(s <= t ? v.x : 0.f, (s + 1) <= t ? v.y : 0.f); }
        bf16_t* WA = (bf16_t*)(ws + WS_WA); bf16_t* WX = (bf16_t*)(ws + WS_WX);
        for (int i = gt; i < DEPTH * 16 * 64 * 64; i += NT) { const int d = i & 63, e = (i >> 6) & 63, lh = i >> 12;
            const float va = in_wa[(size_t)lh * 4096 + d * 64 + e], vx = in_wx[(size_t)lh * 4096 + d * 64 + e];
            WA[i] = (bf16_t)(cvt_pk_bf16(va, 0.f) & 0xffffu); WX[i] = (bf16_t)(cvt_pk_bf16(vx, 0.f) & 0xffffu); }
    }
}

__device__ __forceinline__ void p1_prologue(LAS unsigned char* lds) {
    const int tid = launder(threadIdx.x), wid = tid >> 6, lane = tid & 63, G = gridDim.x;
    unsigned char* ws = getp<unsigned char>(lds, I_WS);
    const float* MOD = (const float*)(ws + WS_MOD);
    {   const int gt = blockIdx.x * 512 + tid, NT = G * 512; const float* gain = getp<const float>(lds, I_GAIN); float* GP = (float*)(ws + WS_GP);
        for (int i = gt; i < DEPTH * NB * D; i += NT) { const int l = i >> 14, b = (i >> 10) & 15, col = i & 1023; GP[i] = gain[l * D + col] * (1.f + MOD[(size_t)(l * 16 + b) * 3072 + 1024 + col]); } }
    {   const float* xin = getp<const float>(lds, I_X); const float* gain = getp<const float>(lds, I_GAIN); bf16_t* H = (bf16_t*)(ws + WS_H); float* RSS = (float*)(ws + WS_RSS);
        const int gw = blockIdx.x * 8 + wid, NGW = G * 8;
        for (int row = gw; row < M; row += NGW) {
            const int b = row >> 11;
            const f32x4* xr = (const f32x4*)(xin + (size_t)row * D) + lane;
            f32x4 v[4]; float ss = 0.f;
#pragma unroll
            for (int j = 0; j < 4; ++j) { v[j] = xr[64 * j]; ss += (v[j].x * v[j].x + v[j].y * v[j].y) + (v[j].z * v[j].z + v[j].w * v[j].w); }
            ss = wave_sum(ss);
            if (lane < 16) RSS[(size_t)row * 16 + lane] = lane == 0 ? ss : 0.f;
#pragma unroll
            for (int j = 0; j < 4; ++j) { const int col = 4 * lane + 256 * j;
                const f32x4 g = *(const f32x4*)(gain + col), sc = *(const f32x4*)(MOD + (size_t)b * 3072 + 1024 + col);
                const f32x4 o = v[j] * g * (sc + 1.f);
                *(u32x2*)(H + (size_t)row * D + col) = (u32x2){cvt_pk_bf16(o.x, o.y), cvt_pk_bf16(o.z, o.w)}; }
        }
    }
    {
        float* BIAS = (float*)(ws + WS_BIAS); const bf16_t* WT = (const bf16_t*)(ws + WS_WIN);
        const int gw = blockIdx.x * 8 + wid, NGW = G * 8, fr = lane & 15, fq = lane >> 4;
        for (int it = gw; it < DEPTH * (NIN / 16); it += NGW) {
            const int l = it / (NIN / 16), n0 = (it % (NIN / 16)) * 16;
            const bf16_t* wrow = WT + ((size_t)l * NIN + n0 + fr) * D + 8 * fq;
            const float* srow = MOD + (size_t)(l * 16 + fr) * 3072 + 8 * fq;
            f32x4 acc = (f32x4){0.f, 0.f, 0.f, 0.f};
#pragma unroll 8
            for (int ks = 0; ks < 32; ++ks) {
                const bf16x8 bfrag = *(const bf16x8*)(wrow + 32 * ks);
                const f32x4 s0 = *(const f32x4*)(srow + 32 * ks), s1 = *(const f32x4*)(srow + 32 * ks + 4);
                const u32x4 ap = (u32x4){cvt_pk_bf16(s0.x, s0.y), cvt_pk_bf16(s0.z, s0.w), cvt_pk_bf16(s1.x, s1.y), cvt_pk_bf16(s1.z, s1.w)};
                acc = __builtin_amdgcn_mfma_f32_16x16x32_bf16(__builtin_bit_cast(bf16x8, ap), bfrag, acc, 0, 0, 0);
            }
#pragma unroll
            for (int e = 0; e < 4; ++e) BIAS[(size_t)(l * 16 + 4 * fq + e) * NIN + n0 + fr] = acc[e];
        }
    }
}

__device__ __forceinline__ void norm_phase(const float* xin, bf16_t* H, const float* gain, const float* modl) {
    const int tid = launder(threadIdx.x), wid = tid >> 6, lane = tid & 63;
    const int gw = blockIdx.x * 8 + wid, NGW = gridDim.x * 8;
    for (int row = gw; row < M; row += NGW) {
        const int b = row >> 11;
        const f32x4* xr = (const f32x4*)(xin + (size_t)row * D) + lane;
        f32x4 v[4]; float ss = 0.f;
#pragma unroll
        for (int j = 0; j < 4; ++j) { v[j] = xr[64 * j]; ss += (v[j].x * v[j].x + v[j].y * v[j].y) + (v[j].z * v[j].z + v[j].w * v[j].w); }
        const float rstd = rsqrtf(wave_sum(ss) * (1.f / D) + EPS);
#pragma unroll
        for (int j = 0; j < 4; ++j) { const int col = 4 * lane + 256 * j;
            const f32x4 g = *(const f32x4*)(gain + col), sh = *(const f32x4*)(modl + (size_t)b * 3072 + col), sc = *(const f32x4*)(modl + (size_t)b * 3072 + 1024 + col);
            const f32x4 o = v[j] * rstd * g * (sc + 1.f) + sh;
            *(u32x2*)(H + (size_t)row * D + col) = (u32x2){cvt_pk_bf16(o.x, o.y), cvt_pk_bf16(o.z, o.w)}; }
    }
}
__device__ __forceinline__ void final_norm(float* x, const float* gain) {
    const int tid = launder(threadIdx.x), wid = tid >> 6, lane = tid & 63;
    const int gw = blockIdx.x * 8 + wid, NGW = gridDim.x * 8;
    for (int row = gw; row < M; row += NGW) {
        f32x4* xr = (f32x4*)(x + (size_t)row * D) + lane;
        f32x4 v[4]; float ss = 0.f;
#pragma unroll
        for (int j = 0; j < 4; ++j) { v[j] = xr[64 * j]; ss += (v[j].x * v[j].x + v[j].y * v[j].y) + (v[j].z * v[j].z + v[j].w * v[j].w); }
        const float rstd = rsqrtf(wave_sum(ss) * (1.f / D) + EPS);
#pragma unroll
        for (int j = 0; j < 4; ++j) { const f32x4 g = *(const f32x4*)(gain + 4 * lane + 256 * j); xr[64 * j] = v[j] * rstd * g; }
    }
}

struct U8 { u32x4 a, b; };
__device__ __forceinline__ U8 ld16(const bf16_t* p, bool ok) { U8 r; if (ok) { r.a = *(const u32x4*)p; r.b = *(const u32x4*)(p + 8); } else { r.a = (u32x4){0u, 0u, 0u, 0u}; r.b = r.a; } return r; }
__device__ __forceinline__ void unpack16(const U8& u, float (&o)[16]) {
    o[0] = bflo(u.a.x); o[1] = bfhi(u.a.x); o[2] = bflo(u.a.y); o[3] = bfhi(u.a.y); o[4] = bflo(u.a.z); o[5] = bfhi(u.a.z); o[6] = bflo(u.a.w); o[7] = bfhi(u.a.w);
    o[8] = bflo(u.b.x); o[9] = bfhi(u.b.x); o[10] = bflo(u.b.y); o[11] = bfhi(u.b.y); o[12] = bflo(u.b.z); o[13] = bfhi(u.b.z); o[14] = bflo(u.b.w); o[15] = bfhi(u.b.w);
}
template <int N> __device__ __forceinline__ float dpp_shr(float v, float ident) {
    return __builtin_bit_cast(float, __builtin_amdgcn_update_dpp(__builtin_bit_cast(int, ident), __builtin_bit_cast(int, v), 0x110 + N, 0xf, 0xf, false));
}
template <int N> __device__ __forceinline__ unsigned dppi(unsigned v, unsigned old) { return (unsigned)__builtin_amdgcn_update_dpp((int)old, (int)v, 0x110 + N, 0xf, 0xf, false); }
template <int N> __device__ __forceinline__ U8 shr_rows(const U8& cur, const U8& halo) { U8 r;
    r.a.x = dppi<N>(cur.a.x, halo.a.x); r.a.y = dppi<N>(cur.a.y, halo.a.y); r.a.z = dppi<N>(cur.a.z, halo.a.z); r.a.w = dppi<N>(cur.a.w, halo.a.w);
    r.b.x = dppi<N>(cur.b.x, halo.b.x); r.b.y = dppi<N>(cur.b.y, halo.b.y); r.b.z = dppi<N>(cur.b.z, halo.b.z); r.b.w = dppi<N>(cur.b.w, halo.b.w); return r; }
template <int N> __device__ __forceinline__ float row_bcast(float v) { return __builtin_bit_cast(float, __builtin_amdgcn_update_dpp(0, __builtin_bit_cast(int, v), 0x150 + N, 0xf, 0xf, true)); }
template <int N> __device__ __forceinline__ float fmac_bc(float acc, float k, float x) { asm("v_fmac_f32_dpp %0, %1, %2 row_newbcast:%3 row_mask:0xf bank_mask:0xf" : "+v"(acc) : "v"(k), "v"(x), "n"(N)); return acc; }
template <int N> __device__ __forceinline__ float mul_bc(float k, float x) { float r; asm("v_mul_f32_dpp %0, %1, %2 row_newbcast:%3 row_mask:0xf bank_mask:0xf" : "=v"(r) : "v"(k), "v"(x), "n"(N)); return r; }
template <int N> __device__ __forceinline__ u32x4 shr4(const u32x4 cur, const u32x4 halo) { u32x4 r; r.x = dppi<N>(cur.x, halo.x); r.y = dppi<N>(cur.y, halo.y); r.z = dppi<N>(cur.z, halo.z); r.w = dppi<N>(cur.w, halo.w); return r; }
__device__ __forceinline__ void unpack8(const u32x4 u, float (&o)[8]) { o[0] = bflo(u.x); o[1] = bfhi(u.x); o[2] = bflo(u.y); o[3] = bfhi(u.y); o[4] = bflo(u.z); o[5] = bfhi(u.z); o[6] = bflo(u.w); o[7] = bfhi(u.w); }
__device__ __forceinline__ U8 lds16(const LAS unsigned char* p) { U8 r; r.a = *(const LAS u32x4*)p; r.b = *(const LAS u32x4*)(p + 16); return r; }
#define SCAN8(N, o) asm volatile("s_nop 1\n" \
    "v_fmac_f32_dpp %8, %8, %0 row_shr:" #N " row_mask:0xf bank_mask:0xf\n v_fmac_f32_dpp %9, %9, %1 row_shr:" #N " row_mask:0xf bank_mask:0xf\n" \
    "v_fmac_f32_dpp %10, %10, %2 row_shr:" #N " row_mask:0xf bank_mask:0xf\n v_fmac_f32_dpp %11, %11, %3 row_shr:" #N " row_mask:0xf bank_mask:0xf\n" \
    "v_fmac_f32_dpp %12, %12, %4 row_shr:" #N " row_mask:0xf bank_mask:0xf\n v_fmac_f32_dpp %13, %13, %5 row_shr:" #N " row_mask:0xf bank_mask:0xf\n" \
    "v_fmac_f32_dpp %14, %14, %6 row_shr:" #N " row_mask:0xf bank_mask:0xf\n v_fmac_f32_dpp %15, %15, %7 row_shr:" #N " row_mask:0xf bank_mask:0xf\n" \
    "v_mul_f32_dpp %0, %0, %0 row_shr:" #N " row_mask:0xf bank_mask:0xf\n v_mul_f32_dpp %1, %1, %1 row_shr:" #N " row_mask:0xf bank_mask:0xf\n" \
    "v_mul_f32_dpp %2, %2, %2 row_shr:" #N " row_mask:0xf bank_mask:0xf\n v_mul_f32_dpp %3, %3, %3 row_shr:" #N " row_mask:0xf bank_mask:0xf\n" \
    "v_mul_f32_dpp %4, %4, %4 row_shr:" #N " row_mask:0xf bank_mask:0xf\n v_mul_f32_dpp %5, %5, %5 row_shr:" #N " row_mask:0xf bank_mask:0xf\n" \
    "v_mul_f32_dpp %6, %6, %6 row_shr:" #N " row_mask:0xf bank_mask:0xf\n v_mul_f32_dpp %7, %7, %7 row_shr:" #N " row_mask:0xf bank_mask:0xf\n" \
    : "+v"(av[o + 0]), "+v"(av[o + 1]), "+v"(av[o + 2]), "+v"(av[o + 3]), "+v"(av[o + 4]), "+v"(av[o + 5]), "+v"(av[o + 6]), "+v"(av[o + 7]), \
      "+v"(bv[o + 0]), "+v"(bv[o + 1]), "+v"(bv[o + 2]), "+v"(bv[o + 3]), "+v"(bv[o + 4]), "+v"(bv[o + 5]), "+v"(bv[o + 6]), "+v"(bv[o + 7]))
#define SCAN_STEP(N) do { SCAN8(N, 0); SCAN8(N, 8); } while (0)

constexpr int MX_VNT = 0, MX_XC = 17408, MX_WAT = 35840, MX_WXT = 45056, MX_PRM = 54272, MX_STAT = 57344, MX_SEG = 59392, MX_HIN = 63488, MX_CARRY = 65536, MX_WS = 66048, MX_PH = 100864, MX_XH = 107776;

__device__ __forceinline__ int mixer_unit_of(int c) { return (c < 256) ? (((2 * (c & 7) + ((c >> 3) >> 4)) << 4) | ((c >> 3) & 15)) : c; }
__device__ __forceinline__ void mixer_fill(LAS unsigned char* lds, int l, int u) {
    const int tid = launder(threadIdx.x);
    unsigned char* ws = getp<unsigned char>(lds, I_WS);
    const int j = u & 15, hh = j >> 1;
    LAS unsigned char* WAT = lds + MX_WAT; LAS unsigned char* WXT = lds + MX_WXT; LAS float* PRM = (LAS float*)(lds + MX_PRM); LAS float* CARRY = (LAS float*)(lds + MX_CARRY);
        {   const int e = tid >> 3, d0 = (tid & 7) * 8;
        const size_t wo = ((size_t)(l * 16 + j) * 64 + e) * 64 + d0;
        *(LAS u32x4*)(WAT + e * 144 + d0 * 2) = *(const u32x4*)((const bf16_t*)(ws + WS_WA) + wo);
        *(LAS u32x4*)(WXT + e * 144 + d0 * 2) = *(const u32x4*)((const bf16_t*)(ws + WS_WX) + wo); }
    for (int i = tid; i < 11 * 64; i += 512) { const int r = i >> 6, ch = 64 * j + (i & 63); float v;
        if (r < 3) v = getp<const float>(lds, I_CAW)[(l * 3 + r) * D + ch];
        else if (r < 7) v = getp<const float>(lds, I_LCW)[(l * 4 + (r - 3)) * D + ch];
        else if (r == 7) v = getp<const float>(lds, I_LCB)[l * D + ch];
        else if (r == 8) v = getp<const float>(lds, I_BA)[l * D + ch];
        else if (r == 9) v = getp<const float>(lds, I_BX)[l * D + ch];
        else v = -8.f * log1pf(expf(-getp<const float>(lds, I_LAM)[l * D + ch]));
        PRM[i] = v; }
    if (tid < 128) CARRY[tid] = 0.f;
    if (tid < 96) { *(LAS unsigned*)(lds + MX_PH + 4 * tid) = 0u; *(LAS unsigned*)(lds + MX_XH + 4 * tid) = 0u; }
#pragma unroll
    for (int i = 0; i < 4; ++i) { const int q = tid + 512 * i, row = q >> 4, c16 = q & 15;
        *(LAS u32x4*)(lds + MX_WS + row * 272 + c16 * 16) = *(const u32x4*)((const bf16_t*)(ws + WS_WSB) + ((size_t)((l * 8 + hh) * 128 + row)) * 128 + c16 * 8); }
}

__device__ __forceinline__ void mixer_phase(LAS unsigned char* lds, int l) {
    const int tid0 = launder(threadIdx.x), wid = __builtin_amdgcn_readfirstlane(tid0 >> 6);
    unsigned char* ws = getp<unsigned char>(lds, I_WS);
    const bf16_t* P = (const bf16_t*)(ws + WS_P); const bf16_t* QA = (const bf16_t*)(ws + WS_QA); const bf16_t* V = (const bf16_t*)(ws + WS_V); const bf16_t* QS = (const bf16_t*)(ws + WS_QS);
    const bf16_t* XR = (const bf16_t*)(ws + WS_XR); const bf16_t* QR = (const bf16_t*)(ws + WS_QR); const bf16_t* SGA = (const bf16_t*)(ws + WS_SGA);
    const float* VST = (const float*)(ws + WS_VST); bf16_t* MRG = (bf16_t*)(ws + WS_MRG);
    LAS unsigned char* VNT = lds + MX_VNT; LAS unsigned char* XC = lds + MX_XC; LAS unsigned char* WAT = lds + MX_WAT; LAS unsigned char* WXT = lds + MX_WXT;
    LAS float* PRM = (LAS float*)(lds + MX_PRM); LAS f32x2* STAT = (LAS f32x2*)(lds + MX_STAT); LAS f32x2* SEG = (LAS f32x2*)(lds + MX_SEG);
    LAS float* HIN = (LAS float*)(lds + MX_HIN); LAS float* CARRY = (LAS float*)(lds + MX_CARRY);
    for (int u0 = blockIdx.x; u0 < 256; u0 += gridDim.x) {
        int u = mixer_unit_of(u0); asm volatile("" : "+s"(u));
        const int b = u >> 4, j = u & 15, hh = j >> 1;
        const int tid = launder(tid0), lane0 = tid & 63, fr = lane0 & 15;
        __syncthreads();
        if (u0 != (int)blockIdx.x) mixer_fill(lds, l, u);
        const float bsv = getp<const float>(lds, I_SB)[(l * 8 + hh) * 128 + 16 * wid + fr];
        float kR[5], kA[3];
        __syncthreads();
#pragma unroll
        for (int r = 0; r < 5; ++r) kR[r] = PRM[(3 + r) * 64 + lane0];
#pragma unroll
        for (int r = 0; r < 3; ++r) kA[r] = PRM[r * 64 + lane0];
        bf16x8 waf[4][2];
#pragma unroll
        for (int nt = 0; nt < 4; ++nt)
#pragma unroll
            for (int ks = 0; ks < 2; ++ks) waf[nt][ks] = *(const LAS bf16x8*)(WAT + (16 * ((lane0 & 15) >> 2) + (lane0 & 3) + 4 * nt) * 144 + (32 * ks + 8 * (lane0 >> 4)) * 2);
        bf16x8 wsf[4];
#pragma unroll
        for (int ks = 0; ks < 4; ++ks) wsf[ks] = *(const LAS bf16x8*)(lds + MX_WS + (16 * wid + fr) * 272 + (32 * ks + 8 * (lane0 >> 4)) * 2);
        unsigned cV[8], nV[8]; U8 cP, cX, cQA, cSG, cQS, cQR, nP, nX, nQA, nSG, nQS, nQR; f32x4 nS;
        {   const int lane = launder(lane0), fr = lane & 15, fq = lane >> 4, tid = wid * 64 + lane, R = tid >> 5, C = tid & 31;
            const int r0 = b * SEQ; const unsigned eoff = (unsigned)((((r0 >> 4) + wid) * 64 + 4 * j + fq) * 256 + fr * 16);
#pragma unroll
            for (int i = 0; i < 8; ++i) cV[i] = *(const unsigned*)(V + (unsigned)((((r0 >> 4) + (R >> 1)) * 64 + 4 * j + (C >> 3)) * 256 + (8 * (R & 1) + i) * 16 + 2 * (C & 7)));
            cP = ld16(P + eoff, true); cX = ld16(XR + eoff, true); cQA = ld16(QA + eoff, true); cSG = ld16(SGA + eoff, true); cQS = ld16(QS + eoff, true); cQR = ld16(QR + eoff, true);
            {   const unsigned so = (unsigned)((((((r0 + (tid >> 2)) >> 4) * 8 + hh) * 8 + 2 * (tid & 3)) * 16 + ((tid >> 2) & 15)) * 2);
                const f32x2 sa = *(const f32x2*)(VST + so), sb = *(const f32x2*)(VST + so + 32); const f32x4 sv = (f32x4){sa.x, sa.y, sb.x, sb.y};
                float sm = sv.x + sv.z, sq = sv.y + sv.w; sm += __shfl_xor(sm, 1); sq += __shfl_xor(sq, 1); sm += __shfl_xor(sm, 2); sq += __shfl_xor(sq, 2);
                const float mean = sm * (1.f / 128.f), var = fmaxf(sq * (1.f / 128.f) - mean * mean, 0.f); if ((tid & 3) == 0) STAT[tid >> 2] = (f32x2){mean, rsqrtf(var + EPS)}; }
            if (fr >= 13 && wid < 7) { LAS unsigned char* hp = lds + MX_PH + ((wid + 1) * 3 + (fr - 13)) * 128 + 32 * fq; LAS unsigned char* hx = hp + (MX_XH - MX_PH);
                *(LAS u32x4*)hp = cP.a; *(LAS u32x4*)(hp + 16) = cP.b; *(LAS u32x4*)hx = cX.a; *(LAS u32x4*)(hx + 16) = cX.b; }
        }
        __syncthreads();
        for (int c = 0; c < 16; ++c) {
            const int lane = launder(lane0), fr = lane & 15, fq = lane >> 4, tid = wid * 64 + lane;
            const int r0 = b * SEQ + c * 128, trow = 16 * wid + fr;
            const unsigned moff = (unsigned)((r0 + trow) * D + 64 * j + 16 * fq);
            const unsigned eoff = (unsigned)((((r0 >> 4) + wid) * 64 + 4 * j + fq) * 256 + fr * 16);
            const int R = tid >> 5, C = tid & 31;
            const int par = c & 1; const bool more = c < 15;
            if (wid == 7 && fr >= 13) {
                LAS unsigned char* hp = lds + MX_PH + (((par ^ 1) * 9) * 3 + (fr - 13)) * 128 + 32 * fq; LAS unsigned char* hx = hp + (MX_XH - MX_PH);
                *(LAS u32x4*)hp = cP.a; *(LAS u32x4*)(hp + 16) = cP.b; *(LAS u32x4*)hx = cX.a; *(LAS u32x4*)(hx + 16) = cX.b; }
            {   float lo[8], hi[8];
#pragma unroll
                for (int i = 0; i < 8; ++i) { const f32x2 st = STAT[par * 128 + 8 * R + i]; lo[i] = (bflo(cV[i]) - st.x) * st.y; hi[i] = (bfhi(cV[i]) - st.x) * st.y; }
                *(LAS u32x4*)(VNT + (2 * C) * 272 + 16 * R) = (u32x4){cvt_pk_bf16(lo[0], lo[1]), cvt_pk_bf16(lo[2], lo[3]), cvt_pk_bf16(lo[4], lo[5]), cvt_pk_bf16(lo[6], lo[7])};
                *(LAS u32x4*)(VNT + (2 * C + 1) * 272 + 16 * R) = (u32x4){cvt_pk_bf16(hi[0], hi[1]), cvt_pk_bf16(hi[2], hi[3]), cvt_pk_bf16(hi[4], hi[5]), cvt_pk_bf16(hi[6], hi[7])};
            }
            float outv[16], xc[16];
            const LAS unsigned char* hbase = lds + MX_PH + (par * 9 + wid) * 384 + 32 * fq;
#pragma unroll
            for (int hf = 0; hf < 2; ++hf) {
                float x0[8], x1[8], x2[8], x3[8];
                {   const LAS unsigned char* hx = hbase + (MX_XH - MX_PH) + 16 * hf; const u32x4 cx = hf ? cX.b : cX.a;
                    u32x4 h1 = (u32x4){0u, 0u, 0u, 0u}, h2 = h1, h3 = h1;
                    if (fr < 3) { h1 = *(const LAS u32x4*)(hx + 2 * 128); h2 = *(const LAS u32x4*)(hx + min(1 + fr, 2) * 128); h3 = *(const LAS u32x4*)(hx + fr * 128); }
                    unpack8(shr4<1>(cx, h1), x1); unpack8(shr4<2>(cx, h2), x2); unpack8(shr4<3>(cx, h3), x3); unpack8(cx, x0); }
#define CONVR(i) xc[8 * hf + i] = fmac_bc<8 * HF + i>(fmac_bc<8 * HF + i>(fmac_bc<8 * HF + i>(fmac_bc<8 * HF + i>(row_bcast<8 * HF + i>(kR[4]), kR[0], x3[i]), kR[1], x2[i]), kR[2], x1[i]), kR[3], x0[i])
                if (hf == 0) { constexpr int HF = 0; CONVR(0); CONVR(1); CONVR(2); CONVR(3); CONVR(4); CONVR(5); CONVR(6); CONVR(7); }
                else { constexpr int HF = 1; CONVR(0); CONVR(1); CONVR(2); CONVR(3); CONVR(4); CONVR(5); CONVR(6); CONVR(7); }
#undef CONVR
                *(LAS u32x4*)(XC + trow * 144 + 32 * fq + 16 * hf) = (u32x4){cvt_pk_bf16(xc[8 * hf + 0], xc[8 * hf + 1]), cvt_pk_bf16(xc[8 * hf + 2], xc[8 * hf + 3]), cvt_pk_bf16(xc[8 * hf + 4], xc[8 * hf + 5]), cvt_pk_bf16(xc[8 * hf + 6], xc[8 * hf + 7])};
            }
#pragma unroll
            for (int hf = 0; hf < 2; ++hf) {
                float p0[8], p1[8], p2[8], qa[8], sg[8];
                {   const u32x4 cp = hf ? cP.b : cP.a;
                    u32x4 h1 = (u32x4){0u, 0u, 0u, 0u}, h2 = h1;
                    if (fr < 2) { h1 = *(const LAS u32x4*)(hbase + 2 * 128 + 16 * hf); h2 = *(const LAS u32x4*)(hbase + (1 + fr) * 128 + 16 * hf); }
                    unpack8(shr4<1>(cp, h1), p1); unpack8(shr4<2>(cp, h2), p2); unpack8(cp, p0); unpack8(hf ? cQA.b : cQA.a, qa); unpack8(hf ? cSG.b : cSG.a, sg); }
#define CONVA(i) outv[8 * hf + i] = sg[i] * qa[i] * fmac_bc<8 * HF + i>(fmac_bc<8 * HF + i>(mul_bc<8 * HF + i>(kA[0], p2[i]), kA[1], p1[i]), kA[2], p0[i])
                if (hf == 0) { constexpr int HF = 0; CONVA(0); CONVA(1); CONVA(2); CONVA(3); CONVA(4); CONVA(5); CONVA(6); CONVA(7); }
                else { constexpr int HF = 1; CONVA(0); CONVA(1); CONVA(2); CONVA(3); CONVA(4); CONVA(5); CONVA(6); CONVA(7); }
#undef CONVA
            }
            {
                const int rn = more ? r0 + 128 : r0; const unsigned noff = (unsigned)((((rn >> 4) + wid) * 64 + 4 * j + fq) * 256 + fr * 16);
#pragma unroll
                for (int i = 0; i < 8; ++i) nV[i] = *(const unsigned*)(V + (unsigned)((((rn >> 4) + (R >> 1)) * 64 + 4 * j + (C >> 3)) * 256 + (8 * (R & 1) + i) * 16 + 2 * (C & 7)));
                nP = ld16(P + noff, true); nX = ld16(XR + noff, true);
                {   const unsigned so = (unsigned)((((((rn + (tid >> 2)) >> 4) * 8 + hh) * 8 + 2 * (tid & 3)) * 16 + ((tid >> 2) & 15)) * 2);
                    const f32x2 sa = *(const f32x2*)(VST + so), sb = *(const f32x2*)(VST + so + 32); nS = (f32x4){sa.x, sa.y, sb.x, sb.y}; }
            }
            float av[16], bv[16];
            {   bf16x8 xcf[2];
#pragma unroll
                for (int ks = 0; ks < 2; ++ks) xcf[ks] = *(const LAS bf16x8*)(XC + trow * 144 + (32 * ks + 8 * fq) * 2);
                const int erow = 16 * (fr >> 2) + (fr & 3);
#pragma unroll
                for (int nt = 0; nt < 4; ++nt) { f32x4 ar = (f32x4){0.f, 0.f, 0.f, 0.f}, ai = ar;
#pragma unroll
                    for (int ks = 0; ks < 2; ++ks) { const bf16x8 wx = *(const LAS bf16x8*)(WXT + (erow + 4 * nt) * 144 + (32 * ks + 8 * fq) * 2);
                        ar = __builtin_amdgcn_mfma_f32_16x16x32_bf16(waf[nt][ks], xcf[ks], ar, 0, 0, 0); ai = __builtin_amdgcn_mfma_f32_16x16x32_bf16(wx, xcf[ks], ai, 0, 0, 0); }
                    const int o = 16 * fq + 4 * nt;
                    const f32x4 ba = *(const LAS f32x4*)(PRM + 8 * 64 + o), bx = *(const LAS f32x4*)(PRM + 9 * 64 + o), nl = *(const LAS f32x4*)(PRM + 10 * 64 + o);
#pragma unroll
                    for (int e = 0; e < 4; ++e) { const int i = 4 * nt + e; const float r = sigm(ar[e] + ba[e]), ig = sigm(ai[e] + bx[e]); const float la = nl[e] * r;
                        const float aa = __expf(la); const float m2 = fmaf(-aa, aa, 1.f);
                        av[i] = aa; bv[i] = __builtin_amdgcn_sqrtf(fmaxf(m2, 0.f)) * ig * xc[i]; }
                    }
            }
            SCAN_STEP(1); SCAN_STEP(2); SCAN_STEP(4); SCAN_STEP(8);
            if (fr == 15) {
#pragma unroll
                for (int i = 0; i < 16; ++i) SEG[wid * 64 + 16 * fq + i] = (f32x2){av[i], bv[i]};
            }
            {
                const int rn = more ? r0 + 128 : r0; const unsigned noff = (unsigned)((((rn >> 4) + wid) * 64 + 4 * j + fq) * 256 + fr * 16);
                nQA = ld16(QA + noff, true); nSG = ld16(SGA + noff, true); }
            __syncthreads();
            {   float qs[16]; unpack16(cQS, qs);
                const int drow = 16 * (fr >> 2) + (fr & 3);
#pragma unroll
                for (int nt = 0; nt < 4; ++nt) { f32x4 z = (f32x4){0.f, 0.f, 0.f, 0.f};
#pragma unroll
                    for (int ks = 0; ks < 4; ++ks) { const bf16x8 af = *(const LAS bf16x8*)(VNT + (drow + 4 * nt) * 272 + (32 * ks + 8 * fq) * 2);
                        z = __builtin_amdgcn_mfma_f32_16x16x32_bf16(af, wsf[ks], z, 0, 0, 0); }
#pragma unroll
                    for (int e = 0; e < 4; ++e) outv[4 * nt + e] += qs[4 * nt + e] * (z[e] + bsv);
                    }
            }
            {   const int rn = more ? r0 + 128 : r0; const unsigned noff = (unsigned)((((rn >> 4) + wid) * 64 + 4 * j + fq) * 256 + fr * 16);
                nQS = ld16(QS + noff, true); nQR = ld16(QR + noff, true); }
            {   const int ch = lane; float h = CARRY[par * 64 + ch];
                for (int w2 = 0; w2 < wid; ++w2) { const f32x2 s = SEG[w2 * 64 + ch]; h = s.x * h + s.y; }
                HIN[wid * 64 + ch] = h;
                if (wid == 7) { const f32x2 s = SEG[7 * 64 + ch]; CARRY[(par ^ 1) * 64 + ch] = s.x * h + s.y; }
            }
            if (more) {
                {   float sm = nS.x + nS.z, sq = nS.y + nS.w; sm += __shfl_xor(sm, 1); sq += __shfl_xor(sq, 1); sm += __shfl_xor(sm, 2); sq += __shfl_xor(sq, 2);
                    const float mean = sm * (1.f / 128.f), var = fmaxf(sq * (1.f / 128.f) - mean * mean, 0.f); if ((tid & 3) == 0) STAT[(par ^ 1) * 128 + (tid >> 2)] = (f32x2){mean, rsqrtf(var + EPS)}; }
                if (fr >= 13 && wid < 7) { LAS unsigned char* hp = lds + MX_PH + (((par ^ 1) * 9 + wid + 1) * 3 + (fr - 13)) * 128 + 32 * fq; LAS unsigned char* hx = hp + (MX_XH - MX_PH);
                    *(LAS u32x4*)hp = nP.a; *(LAS u32x4*)(hp + 16) = nP.b; *(LAS u32x4*)hx = nX.a; *(LAS u32x4*)(hx + 16) = nX.b; }
            }
            __syncthreads();
            {   float qr[16]; unpack16(cQR, qr);
#pragma unroll
                for (int q4 = 0; q4 < 4; ++q4) { const f32x4 hin = *(const LAS f32x4*)(HIN + wid * 64 + 16 * fq + 4 * q4);
#pragma unroll
                    for (int e = 0; e < 4; ++e) { const int i = 4 * q4 + e; outv[i] += qr[i] * (bv[i] + av[i] * hin[e]); } }
            }
            *(u32x4*)(MRG + moff) = (u32x4){cvt_pk_bf16(outv[0], outv[1]), cvt_pk_bf16(outv[2], outv[3]), cvt_pk_bf16(outv[4], outv[5]), cvt_pk_bf16(outv[6], outv[7])};
            *(u32x4*)(MRG + moff + 8) = (u32x4){cvt_pk_bf16(outv[8], outv[9]), cvt_pk_bf16(outv[10], outv[11]), cvt_pk_bf16(outv[12], outv[13]), cvt_pk_bf16(outv[14], outv[15])};
            cP = nP; cX = nX; cQA = nQA; cSG = nSG; cQS = nQS; cQR = nQR;
#pragma unroll
            for (int i = 0; i < 8; ++i) cV[i] = nV[i];
        }
    }
}

#define XB_TMO      128
#define XB_XCNT(j)  (256  + 64 * (j))
#define XB_XSUB(j)  (1280 + 64 * (j))
#define XB_XGEN(j)  (2304 + 64 * (j))
#define XB_TOP      3328
#define XB_TOPGEN   3392
#define XCD_BAR_WORDS 3456
#define XB_SPIN_CAP (1u << 18)

__device__ __forceinline__ unsigned xb_ld(unsigned* p)              { return __hip_atomic_load(p, __ATOMIC_RELAXED, __HIP_MEMORY_SCOPE_AGENT); }
__device__ __forceinline__ unsigned xb_add(unsigned* p, unsigned v) { return __hip_atomic_fetch_add(p, v, __ATOMIC_RELAXED, __HIP_MEMORY_SCOPE_AGENT); }
__device__ __forceinline__ unsigned xb_xcc_id() { return (unsigned)__builtin_amdgcn_s_getreg((3 << 11) | 20) & 0xFu; }
#define XB_SPIN(cond, bar) do { unsigned _sp = 0; while (cond) { __builtin_amdgcn_s_sleep(1); \
    if ((++_sp & 255u) == 0u) { if (xb_ld(&(bar)[XB_TMO])) break; if (_sp > XB_SPIN_CAP) { atomicAdd(&(bar)[XB_TMO], 1u); break; } } } } while (0)

struct XcdBarrier {
    unsigned* bar; unsigned x;
    volatile LAS unsigned* st;
};

__device__ __forceinline__ XcdBarrier xcd_barrier_post(unsigned* bar, volatile LAS unsigned* st) {
    XcdBarrier b; b.bar = bar; b.x = xb_xcc_id(); b.st = st;
    if (threadIdx.x == 0) (void)xb_add(&bar[XB_XCNT(b.x)], 1u);
    return b;
}
__device__ __forceinline__ void xcd_barrier_complete(unsigned* bar, unsigned x, unsigned& nloc, unsigned& nx) {
    const unsigned G = gridDim.x * gridDim.y * gridDim.z;
    unsigned sum, cnt, mine, sp = 0u;
    for (;;) {
        sum = 0u; cnt = 0u; mine = 0u;
#pragma unroll
        for (unsigned j = 0; j < 16; ++j) { const unsigned c = xb_ld(&bar[XB_XCNT(j)]); sum += c; cnt += (c > 0u) ? 1u : 0u; mine = (j == x) ? c : mine; }
        if (sum == G) break;
        __builtin_amdgcn_s_sleep(1);
        if ((++sp & 255u) == 0u) { if (xb_ld(&bar[XB_TMO])) break; if (sp > XB_SPIN_CAP) { atomicAdd(&bar[XB_TMO], 1u); break; } }
    }
    nloc = mine > 0u ? mine : 1u; nx = cnt > 0u ? cnt : 1u;
}

__device__ __forceinline__ void xcd_barrier(const XcdBarrier& b) {
    asm volatile("s_waitcnt vmcnt(0)" ::: "memory");
    __syncthreads();
    if (threadIdx.x == 0) {
        unsigned bx = b.x; asm volatile("" : "+s"(bx));
        unsigned* bar = b.bar; asm volatile("" : "+s"(bar));
        __builtin_amdgcn_s_waitcnt(0);
        unsigned nloc = b.st[0], nx = b.st[1];
        if (nloc == 0u) { xcd_barrier_complete(bar, bx, nloc, nx); b.st[0] = nloc; b.st[1] = nx; }
        const unsigned old = xb_add(&bar[XB_XSUB(bx)], 1u);
        const unsigned gen = old / nloc;
        if (old + 1u == (gen + 1u) * nloc) {
            __builtin_amdgcn_fence(__ATOMIC_RELEASE, "agent");
            asm volatile("s_waitcnt vmcnt(0)" ::: "memory");
            const unsigned og = xb_add(&bar[XB_TOP], 1u);
            const unsigned tg = og / nx;
            if (og + 1u == (tg + 1u) * nx) xb_add(&bar[XB_TOPGEN], 1u);
            else XB_SPIN(xb_ld(&bar[XB_TOPGEN]) == tg, bar);
            __builtin_amdgcn_fence(__ATOMIC_ACQUIRE, "agent");
            xb_add(&bar[XB_XGEN(bx)], 1u);
            asm volatile("s_waitcnt vmcnt(0)" ::: "memory");
        } else {
            XB_SPIN(xb_ld(&bar[XB_XGEN(bx)]) == gen, bar);
            __builtin_amdgcn_fence(__ATOMIC_ACQUIRE, "agent");
            asm volatile("s_waitcnt vmcnt(0)" ::: "memory");
        }
    }
    __syncthreads();
}


__global__ void __launch_bounds__(512, 2) __attribute__((target("no-packed-fp32-ops"))) fwd_megakernel(Args a) {
    extern __shared__ __attribute__((aligned(16))) unsigned char lds_raw[];
    LAS unsigned char* lds = (LAS unsigned char*)lds_raw;
    cg::grid_group grid = cg::this_grid();
    if (threadIdx.x == 0) {
        LAS unsigned long long* PT = (LAS unsigned long long*)(lds + PT_OFF);
        PT[0] = (unsigned long long)a.in[0]; PT[1] = (unsigned long long)a.in[1]; PT[2] = (unsigned long long)a.in[2]; PT[3] = (unsigned long long)a.in[3]; PT[4] = (unsigned long long)a.in[4];
        PT[5] = (unsigned long long)a.in[5]; PT[6] = (unsigned long long)a.in[6]; PT[7] = (unsigned long long)a.in[7]; PT[8] = (unsigned long long)a.in[8]; PT[9] = (unsigned long long)a.in[9];
        PT[10] = (unsigned long long)a.in[10]; PT[11] = (unsigned long long)a.in[11]; PT[12] = (unsigned long long)a.in[12]; PT[13] = (unsigned long long)a.in[13]; PT[14] = (unsigned long long)a.in[14];
        PT[15] = (unsigned long long)a.in[15]; PT[16] = (unsigned long long)a.in[16]; PT[17] = (unsigned long long)a.in[17]; PT[18] = (unsigned long long)a.out; PT[19] = (unsigned long long)a.ws;
    }
    if (threadIdx.x == 0) { *(LAS unsigned*)(lds + LDS_BARST) = 0u; *(LAS unsigned*)(lds + LDS_BARST + 4) = 0u; }
    __syncthreads();
    const int G = gridDim.x;
    {   pg8::StaticOrder S1; S1.init(M, NIN, G, (int)blockIdx.x); pm_slots_init(lds, S1); }
    const XcdBarrier bar = xcd_barrier_post((unsigned*)(a.ws + WS_CTL), (volatile LAS unsigned*)(lds + LDS_BARST));

    p0_prologue(lds);
    grid.sync();
    p1_prologue(lds);
    xcd_barrier(bar);
    for (int l = 0; l < DEPTH; ++l) {
        {   unsigned char* ws = getp<unsigned char>(lds, I_WS);
            pg8::Gemm g{(const bf16_t*)(ws + WS_H), (const bf16_t*)(ws + WS_WIN) + (size_t)l * NIN * D, M, NIN, D};
            pg8::StaticOrder S; S.init(M, NIN, G, (int)blockIdx.x);
            rstd_prelude(lds, (const float*)(ws + WS_RSS));
            EpiG1 E{lds, l};
            pg8::gemm_phase<EpiG1, true>(lds, g, S, E); }
        if (blockIdx.x < 256) mixer_fill(lds, l, mixer_unit_of((int)blockIdx.x));
        xcd_barrier(bar);
        mixer_phase(lds, l);
        xcd_barrier(bar);
        {   unsigned char* ws = getp<unsigned char>(lds, I_WS);
            pg8::Gemm g{(const bf16_t*)(ws + WS_MRG), (const bf16_t*)(ws + WS_WOUT) + (size_t)l * D * D, M, D, D};
            pg8::StaticOrder S; S.init(M, D, G, (int)blockIdx.x);
            EpiG2 E{lds, l};
            pg8::gemm_phase<EpiG2, false>(lds, g, S, E); }
        xcd_barrier(bar);
    }
    final_norm(getp<float>(lds, I_OUT), getp<const float>(lds, I_FG));
}

extern "C" void kernel_launch(void* const* d_in, const int* in_sizes, int n_in, void* d_out, int out_size, void* d_ws, size_t ws_size, hipStream_t stream) {
    static int grid = 0;
    if (grid == 0) {
        if (n_in != 18 || in_sizes[0] != M * D || out_size != M * D || ws_size < WS_END) { fprintf(stderr, "kernel_launch: unexpected shapes (n_in %d, in0 %d, out %d, ws %zu)\n", n_in, n_in > 0 ? in_sizes[0] : -1, out_size, ws_size); grid = -1; return; }
        int dev = 0, cus = 0, per_cu = 0;
        if (hipGetDevice(&dev) != hipSuccess || hipDeviceGetAttribute(&cus, hipDeviceAttributeMultiprocessorCount, dev) != hipSuccess) { fprintf(stderr, "kernel_launch: device query failed\n"); grid = -1; return; }
        if (hipFuncSetAttribute((const void*)fwd_megakernel, hipFuncAttributeMaxDynamicSharedMemorySize, LDS_BYTES) != hipSuccess) { fprintf(stderr, "kernel_launch: hipFuncSetAttribute failed\n"); grid = -1; return; }
        if (hipOccupancyMaxActiveBlocksPerMultiprocessor(&per_cu, (const void*)fwd_megakernel, 512, LDS_BYTES) != hipSuccess || per_cu < 1) { fprintf(stderr, "kernel_launch: occupancy query says %d blocks per CU\n", per_cu); per_cu = 1; }
        (void)hipGetLastError();
        grid = cus * per_cu;
    }
    if (grid < 0) return;
    if (hipMemsetAsync((char*)d_ws + WS_CTL, 0, CTL_BYTES, stream) != hipSuccess) { fprintf(stderr, "kernel_launch: memset of the barrier words failed\n"); return; }
    Args a{};
    for (int i = 0; i < 18; ++i) a.in[i] = (const float*)d_in[i];
    a.out = (float*)d_out; a.ws = (unsigned char*)d_ws;
    void* args[] = {&a};
    const hipError_t e = hipLaunchCooperativeKernel((const void*)fwd_megakernel, dim3(grid), dim3(512), args, LDS_BYTES, stream);
    if (e != hipSuccess) fprintf(stderr, "kernel_launch: cooperative launch failed: %s (grid %d)\n", hipGetErrorString(e), grid);
}
```
